# Optimizing an MI355X kernel written in HIP

```python
import math
import jax
import jax.numpy as jnp
from jax import lax
import numpy as np

D_MODEL = 1024
BATCH = 2
SEQ = 8192
DEPTH = 2

GRID_W = 64
CTX_LEN = 256
EPS = 1e-6
POS_BASE = 10000.0
GROUP_W = D_MODEL // 4
MIX_W = 4 * GROUP_W
SHORT_CONV = 3
HY_W = GROUP_W
HY_ORDER = 2
HY_EMB = 33
HY_BANDS = (HY_EMB - 1) // 2
HY_FFN = 64
HY_FAST_DECAY = 0.3
HY_SLOW_DECAY = 1.5
HY_DECAY_TARGET = 1e-2
HG_H = 4
HG_W = GROUP_W
HG_DK = HG_W // HG_H
GLA_H = 4
GLA_KW = GROUP_W // 2
GLA_VW = GROUP_W
GLA_DK = GLA_KW // GLA_H
GLA_DV = GLA_VW // GLA_H
GLA_RANK = 16
GLA_NORMALIZER = 16.0
ML_H = 4
ML_W = GROUP_W
ML_DH = ML_W // ML_H
CHUNK_GATED = 16
CHUNK_ML = 64
N_EXPERTS = 256
TOP_K = 8
N_EXPERT_GROUPS = 8
TOPK_GROUPS = 4
EXPERT_FF = 256
SHARED_FF = 256
ROUTED_SCALE = 2.5
MOE_BLOCK = 128
IN_SPLITS = (HY_W, HY_W, HY_W,
             HG_W, HG_W, HG_W, HG_W, HG_W,
             GLA_KW, GLA_KW, GLA_VW, GLA_RANK, GLA_RANK, GLA_VW,
             ML_W, ML_W, ML_W, 4 * ML_H, ML_W)
D_IN = 3 * HY_W + 5 * HG_W + 2 * GLA_KW + 2 * GLA_VW + 2 * GLA_RANK + 4 * ML_W + 4 * ML_H

kernel_name = 'hybrid_dit_hyena_hgrn2_gla_mlstm_moe'


def _rms(x, g):
    xf = x.astype(jnp.float32)
    y = xf * lax.rsqrt(jnp.mean(xf * xf, axis=-1, keepdims=True) + EPS)
    return (y * g.astype(jnp.float32)).astype(x.dtype)


def _split(p, sizes):
    out = []
    o = 0
    for s in sizes:
        out.append(p[..., o:o + s])
        o += s
    return out


def _heads(a, n):
    b, t, w = a.shape
    return a.reshape(b, t, n, w // n).transpose(0, 2, 1, 3)


def _head_rms(o, g):
    o = o * lax.rsqrt(jnp.mean(o * o, axis=-1, keepdims=True) + EPS)
    b, n, t, d = o.shape
    return o.transpose(0, 2, 1, 3).reshape(b, t, n * d) * g.astype(jnp.float32)


def _flip(a):
    return jnp.flip(a, axis=2)


def _short_conv(u, w, b):
    ch = u.shape[-1]
    y = lax.conv_general_dilated(u, w.astype(u.dtype)[:, None, :], (1,),
                                 ((SHORT_CONV // 2, SHORT_CONV // 2),),
                                 dimension_numbers=('NWC', 'WIO', 'NWC'),
                                 feature_group_count=ch)
    return y + b.astype(u.dtype)


def _pos_embed_2d(rows, d):
    r = jnp.repeat(jnp.arange(rows, dtype=jnp.float32), GRID_W)
    col = (jnp.arange(rows * GRID_W) % GRID_W).astype(jnp.float32)
    quarter = d // 4
    omega = 1.0 / (POS_BASE ** (jnp.arange(quarter, dtype=jnp.float32) / quarter))

    def axis_emb(p):
        ang = p[:, None] * omega[None, :]
        return jnp.concatenate([jnp.sin(ang), jnp.cos(ang)], axis=-1)

    return jnp.concatenate([axis_emb(r), axis_emb(col)], axis=-1)


def _hyena_spectra(L, w1, b1, w2, b2, w3, freq):
    f32 = jnp.float32
    t = jnp.linspace(0.0, 1.0, L, dtype=f32)[:, None]
    w = 2.0 * math.pi * jnp.arange(L, dtype=f32)[:, None] / L
    bands = jnp.linspace(1e-4, HY_BANDS - 1, HY_BANDS, dtype=f32)[None, :]
    feats = jnp.concatenate([t, jnp.cos(bands * w), -jnp.sin(bands * w)], axis=-1)
    z = jnp.sin(freq[0].astype(f32) * (feats @ w1.astype(f32) + b1.astype(f32)))
    z = jnp.sin(freq[1].astype(f32) * (z @ w2.astype(f32) + b2.astype(f32)))
    h = (z @ w3.astype(f32)).reshape(L, HY_ORDER, 2, HY_W)
    max_decay = math.log(HY_DECAY_TARGET) / HY_FAST_DECAY
    min_decay = math.log(HY_DECAY_TARGET) / HY_SLOW_DECAY
    deltas = jnp.abs(jnp.linspace(min_decay, max_decay, HY_W, dtype=f32))
    h = h * jnp.exp(-t[:, :, None, None] * deltas)
    fwd = h[:, :, 0]
    bwd = h[1:, :, 1][::-1]
    l1 = jnp.sum(jnp.abs(fwd), axis=0) + jnp.sum(jnp.abs(bwd), axis=0)
    filt = jnp.concatenate([fwd, jnp.zeros((1, HY_ORDER, HY_W), f32), bwd], axis=0) / l1
    return jnp.fft.rfft(filt, axis=0)


def _fft_conv(u, spec, bias):
    L = u.shape[1]
    y = jnp.fft.irfft(jnp.fft.rfft(u, n=2 * L, axis=1) * spec, n=2 * L, axis=1)[:, :L]
    return y + u * bias.astype(u.dtype)


def _hyena(parts, conv_w, conv_b, w1, b1, w2, b2, w3, freq, bias, norm_g):
    u = _short_conv(jnp.concatenate(parts, axis=-1), conv_w, conv_b)
    v, x1, x2 = u[..., :HY_W], u[..., HY_W:2 * HY_W], u[..., 2 * HY_W:]
    spec = _hyena_spectra(u.shape[1], w1, b1, w2, b2, w3, freq)
    z = x1 * _fft_conv(v, spec[:, 0], bias[0])
    y = x2 * _fft_conv(z, spec[:, 1], bias[1])
    return _rms(y, norm_g)


def _gla_dir(q, k, v, g, s0, with_out):
    bsz, nh, T, dk = k.shape
    dv = v.shape[-1]
    C = CHUNK_GATED
    n = T // C
    kc = k.reshape(bsz, nh, n, C, dk)
    vc = v.reshape(bsz, nh, n, C, dv)
    b = jnp.cumsum(g.reshape(bsz, nh, n, C, dk), axis=3)
    bl = b[:, :, :, -1]
    ds = jnp.einsum('bhncd,bhncv->bhndv', kc * jnp.exp(bl[:, :, :, None] - b), vc)

    def step(s, inp):
        dec, d = inp
        return dec[..., None] * s + d, s

    s_fin, s_prev = lax.scan(step, s0, (jnp.moveaxis(jnp.exp(bl), 2, 0), jnp.moveaxis(ds, 2, 0)))
    if not with_out:
        return None, s_fin
    s_prev = jnp.moveaxis(s_prev, 0, 2)
    qc = q.reshape(bsz, nh, n, C, dk)
    causal = jnp.tril(jnp.ones((C, C), dtype=bool))[:, :, None]
    diff = b[:, :, :, :, None, :] - b[:, :, :, None, :, :]
    att = jnp.sum(qc[:, :, :, :, None, :] * kc[:, :, :, None, :, :]
                  * jnp.exp(jnp.where(causal, diff, -jnp.inf)), axis=-1)
    o = (jnp.einsum('bhnts,bhnsv->bhntv', att, vc)
         + jnp.einsum('bhntd,bhndv->bhntv', qc * jnp.exp(b), s_prev))
    return o.reshape(bsz, nh, T, dv), s_fin


def _gla_bidir(q, k_f, k_b, v, g_f, g_b, s0_f, s0_b, with_out):
    o_f, s_f = _gla_dir(q, k_f, v, g_f, s0_f, with_out)
    o_b, s_b = _gla_dir(_flip(q), _flip(k_b), _flip(v), _flip(g_b), s0_b, with_out)
    o = o_f + _flip(o_b) if with_out else None
    return o, s_f, s_b


def _hgrn2_seq(parts, lb, norm_g, s0_f, s0_b, with_out):
    q, i, zf, zb, g = parts
    log_lb = jnp.log(lb)
    log_ub = jnp.log1p(-lb)

    def gate(z):
        k = _heads((1.0 - lb) * jax.nn.sigmoid(-z), HG_H)
        lf = _heads(jnp.logaddexp(log_lb, log_ub + jax.nn.log_sigmoid(z)), HG_H)
        return k, lf

    k_f, lf_f = gate(zf)
    k_b, lf_b = gate(zb)
    o, s_f, s_b = _gla_bidir(_heads(jax.nn.silu(q), HG_H), k_f, k_b, _heads(i, HG_H),
                             lf_f, lf_b, s0_f, s0_b, with_out)
    y = _head_rms(o, norm_g) * jax.nn.silu(g) if with_out else None
    return y, s_f, s_b


def _hgrn2(pc, pl, lb, norm_g, with_ctx):
    s0 = jnp.zeros((pl[0].shape[0], HG_H, HG_DK, HG_DK), jnp.float32)
    yc, s_f, s_b = _hgrn2_seq(pc, lb, norm_g, s0, s0, with_ctx)
    y, _, _ = _hgrn2_seq(pl, lb, norm_g, s_f, s_b, True)
    return yc, y


def _gla_seq(parts, a_up, a_b, norm_g, s0_f, s0_b, with_out):
    q, k, v, af, ab, r = parts
    qh = _heads(q, GLA_H) * GLA_DK ** -0.5
    kh = _heads(k, GLA_H)
    vh = _heads(v, GLA_H)
    a_up = a_up.astype(jnp.float32)
    a_b = a_b.astype(jnp.float32)
    g_f = _heads(jax.nn.log_sigmoid(af @ a_up[0] + a_b[0]) / GLA_NORMALIZER, GLA_H)
    g_b = _heads(jax.nn.log_sigmoid(ab @ a_up[1] + a_b[1]) / GLA_NORMALIZER, GLA_H)
    o, s_f, s_b = _gla_bidir(qh, kh, kh, vh, g_f, g_b, s0_f, s0_b, with_out)
    y = _head_rms(o, norm_g) * jax.nn.silu(r) if with_out else None
    return y, s_f, s_b


def _gla(pc, pl, a_up, a_b, norm_g, with_ctx):
    s0 = jnp.zeros((pl[0].shape[0], GLA_H, GLA_DK, GLA_DV), jnp.float32)
    yc, s_f, s_b = _gla_seq(pc, a_up, a_b, norm_g, s0, s0, with_ctx)
    y, _, _ = _gla_seq(pl, a_up, a_b, norm_g, s_f, s_b, True)
    return yc, y


def _mlstm_dir(q, k, v, ig, lf, state0, with_out):
    bsz, nh, T, dh = k.shape
    C = CHUNK_ML
    n = T // C
    kc = k.reshape(bsz, nh, n, C, dh)
    vc = v.reshape(bsz, nh, n, C, dh)
    igc = ig.reshape(bsz, nh, n, C)
    b = jnp.cumsum(lf.reshape(bsz, nh, n, C), axis=-1)
    bl = b[..., -1]
    a = bl[..., None] - b + igc
    ma = jnp.max(a, axis=-1)
    w = jnp.exp(a - ma[..., None])
    ds = jnp.einsum('bhnc,bhncd,bhncv->bhndv', w, kc, vc)
    dn = jnp.einsum('bhnc,bhncd->bhnd', w, kc)

    def step(carry, inp):
        s, nv, m = carry
        bl_, ma_, ds_, dn_ = inp
        m_new = jnp.maximum(bl_ + m, ma_)
        d_old = jnp.exp(bl_ + m - m_new)
        d_new = jnp.exp(ma_ - m_new)
        s_new = d_old[..., None, None] * s + d_new[..., None, None] * ds_
        n_new = d_old[..., None] * nv + d_new[..., None] * dn_
        return (s_new, n_new, m_new), (s, nv, m)

    mv = lambda t_: jnp.moveaxis(t_, 2, 0)
    fin, prev = lax.scan(step, state0, (mv(bl), mv(ma), mv(ds), mv(dn)))
    if not with_out:
        return None, fin
    s_prev, n_prev, m_prev = [jnp.moveaxis(p, 0, 2) for p in prev]
    qc = q.reshape(bsz, nh, n, C, dh)
    causal = jnp.tril(jnp.ones((C, C), dtype=bool))
    dmat = jnp.where(causal, b[..., :, None] - b[..., None, :] + igc[..., None, :], -jnp.inf)
    inter = b + m_prev[..., None]
    m_t = jnp.maximum(inter, jnp.max(dmat, axis=-1))
    wq = jnp.exp(dmat - m_t[..., None]) * jnp.einsum('bhntd,bhnsd->bhnts', qc, kc)
    w_int = jnp.exp(inter - m_t)
    num = (jnp.einsum('bhnts,bhnsv->bhntv', wq, vc)
           + w_int[..., None] * jnp.einsum('bhntd,bhndv->bhntv', qc, s_prev))
    den = jnp.sum(wq, axis=-1) + w_int * jnp.einsum('bhntd,bhnd->bhnt', qc, n_prev)
    h = num / jnp.maximum(jnp.abs(den), jnp.exp(-m_t))[..., None]
    return h.reshape(bsz, nh, T, dh), fin


def _mlstm_seq(parts, conv_w, conv_b, gate_b, norm_g, st_f, st_b, with_out):
    q, k, v, gates, o = parts
    qk = jax.nn.silu(_short_conv(jnp.concatenate([q, k], axis=-1), conv_w, conv_b))
    qh = _heads(qk[..., :ML_W], ML_H)
    kh = _heads(qk[..., ML_W:], ML_H) * ML_DH ** -0.5
    vh = _heads(v, ML_H)
    bsz, T, _ = gates.shape
    gt = (gates.reshape(bsz, T, 4, ML_H) + gate_b.astype(jnp.float32)).transpose(2, 0, 3, 1)
    h_f, fin_f = _mlstm_dir(qh, kh, vh, gt[0], jax.nn.log_sigmoid(gt[1]), st_f, with_out)
    h_b, fin_b = _mlstm_dir(_flip(qh), _flip(kh), _flip(vh), _flip(gt[2]),
                            _flip(jax.nn.log_sigmoid(gt[3])), st_b, with_out)
    y = jax.nn.sigmoid(o) * _head_rms(h_f + _flip(h_b), norm_g) if with_out else None
    return y, fin_f, fin_b


def _mlstm(pc, pl, conv_w, conv_b, gate_b, norm_g, with_ctx):
    bsz = pl[0].shape[0]
    f32 = jnp.float32
    st0 = (jnp.zeros((bsz, ML_H, ML_DH, ML_DH), f32), jnp.zeros((bsz, ML_H, ML_DH), f32),
           jnp.zeros((bsz, ML_H), f32))
    yc, st_f, st_b = _mlstm_seq(pc, conv_w, conv_b, gate_b, norm_g, st0, st0, with_ctx)
    y, _, _ = _mlstm_seq(pl, conv_w, conv_b, gate_b, norm_g, st_f, st_b, True)
    return yc, y


def _moe(t, router_w, router_b, w_gu, w_down, sh_gu, sh_down):
    N, D = t.shape
    scores = jax.nn.sigmoid(t.astype(jnp.float32) @ router_w.astype(jnp.float32))
    sel = scores + router_b.astype(jnp.float32)
    per_group = N_EXPERTS // N_EXPERT_GROUPS
    grp_score = jnp.sum(lax.top_k(sel.reshape(N, N_EXPERT_GROUPS, per_group), 2)[0], axis=-1)
    _, gidx = lax.top_k(grp_score, TOPK_GROUPS)
    gmask = jnp.sum(jax.nn.one_hot(gidx, N_EXPERT_GROUPS, dtype=jnp.float32), axis=1) > 0
    masked = jnp.where(jnp.repeat(gmask, per_group, axis=1), sel, -jnp.inf)
    _, eidx = lax.top_k(masked, TOP_K)
    wsel = jnp.take_along_axis(scores, eidx, axis=1)
    wsel = wsel / jnp.sum(wsel, axis=-1, keepdims=True) * ROUTED_SCALE
    A = N * TOP_K
    flat_e = eidx.reshape(A)
    flat_t = jnp.repeat(jnp.arange(N, dtype=jnp.int32), TOP_K)
    flat_w = wsel.reshape(A)
    order = jnp.argsort(flat_e)
    se, st, sw = flat_e[order], flat_t[order], flat_w[order]
    counts = jnp.bincount(flat_e, length=N_EXPERTS)
    start = jnp.cumsum(counts) - counts
    padded = (counts + MOE_BLOCK - 1) // MOE_BLOCK * MOE_BLOCK
    pad_end = jnp.cumsum(padded)
    pad_start = pad_end - padded
    dest = pad_start[se] + jnp.arange(A, dtype=jnp.int32) - start[se]
    n_blocks = (A + N_EXPERTS * (MOE_BLOCK - 1)) // MOE_BLOCK + 1
    P = n_blocks * MOE_BLOCK
    tok_p = jnp.zeros((P,), jnp.int32).at[dest].set(st)
    w_p = jnp.zeros((P,), jnp.float32).at[dest].set(sw)
    blk_e = jnp.minimum(jnp.searchsorted(pad_end, jnp.arange(n_blocks, dtype=jnp.int32) * MOE_BLOCK,
                                         side='right'), N_EXPERTS - 1)

    def body(acc, blk):
        e, toks, gw = blk
        xb = t[toks]
        a, u = jnp.split(xb @ w_gu[e], 2, axis=-1)
        yb = (jax.nn.silu(a) * u) @ w_down[e]
        return acc.at[toks].add(yb * gw[:, None].astype(yb.dtype)), None

    routed, _ = lax.scan(body, jnp.zeros_like(t),
                         (blk_e, tok_p.reshape(n_blocks, MOE_BLOCK), w_p.reshape(n_blocks, MOE_BLOCK)))
    a, u = jnp.split(t @ sh_gu, 2, axis=-1)
    return routed + (jax.nn.silu(a) * u) @ sh_down


def setup_inputs(seed: int = 0) -> dict:
    key = jax.random.key(seed)
    keys = iter(jax.random.split(key, 48))

    def nrm(shape, scale):
        return jax.random.normal(next(keys), shape, jnp.float32) * scale

    d = D_MODEL
    fb = jnp.linspace(3.0, 6.0, ML_H, dtype=jnp.float32)
    zb = jnp.zeros((ML_H,), jnp.float32)
    ml_base = jnp.stack([zb, fb, zb, fb])
    return {
        'x': nrm((BATCH, SEQ, d), 1.0),
        'c': nrm((BATCH, d), 1.0),
        'ctx': nrm((BATCH, CTX_LEN, d), 1.0),
        'c_ctx': nrm((d,), 1.0),
        'ada_w': nrm((DEPTH, d, 6 * d), 0.5 * d ** -0.5),
        'ada_b': nrm((DEPTH, 6 * d), 0.02),
        'norm_g': 1.0 + nrm((DEPTH, 4, d), 0.05),
        'w_in': nrm((DEPTH, d, D_IN), d ** -0.5),
        'w_out': nrm((DEPTH, MIX_W, d), MIX_W ** -0.5),
        'hy_conv_w': nrm((DEPTH, SHORT_CONV, 3 * HY_W), SHORT_CONV ** -0.5),
        'hy_conv_b': nrm((DEPTH, 3 * HY_W), 0.02),
        'hy_ffn_w1': nrm((DEPTH, HY_EMB, HY_FFN), HY_EMB ** -0.5),
        'hy_ffn_b1': nrm((DEPTH, HY_FFN), 0.1),
        'hy_ffn_w2': nrm((DEPTH, HY_FFN, HY_FFN), HY_FFN ** -0.5),
        'hy_ffn_b2': nrm((DEPTH, HY_FFN), 0.1),
        'hy_ffn_w3': nrm((DEPTH, HY_FFN, HY_ORDER * 2 * HY_W), HY_FFN ** -0.5),
        'hy_freq': 1.0 + nrm((DEPTH, 2, HY_FFN), 0.05),
        'hy_bias': nrm((DEPTH, HY_ORDER, HY_W), 0.5),
        'hy_norm': 1.0 + nrm((DEPTH, HY_W), 0.05),
        'hg_lb_logits': nrm((DEPTH, HG_W), 1.0),
        'hg_norm': 1.0 + nrm((DEPTH, HG_W), 0.05),
        'gla_a_up': nrm((DEPTH, 2, GLA_RANK, GLA_KW), GLA_RANK ** -0.5),
        'gla_a_b': nrm((DEPTH, 2, GLA_KW), 0.1),
        'gla_norm': 1.0 + nrm((DEPTH, GLA_VW), 0.05),
        'ml_conv_w': nrm((DEPTH, SHORT_CONV, 2 * ML_W), SHORT_CONV ** -0.5),
        'ml_conv_b': nrm((DEPTH, 2 * ML_W), 0.02),
        'ml_gate_b': ml_base[None] + nrm((DEPTH, 4, ML_H), 0.1),
        'ml_norm': 1.0 + nrm((DEPTH, ML_W), 0.05),
        'router_w': nrm((DEPTH, d, N_EXPERTS), d ** -0.5),
        'router_b': nrm((DEPTH, N_EXPERTS), 0.01),
        'exp_w_gu': nrm((DEPTH, N_EXPERTS, d, 2 * EXPERT_FF), d ** -0.5),
        'exp_w_down': nrm((DEPTH, N_EXPERTS, EXPERT_FF, d), EXPERT_FF ** -0.5),
        'sh_w_gu': nrm((DEPTH, d, 2 * SHARED_FF), d ** -0.5),
        'sh_w_down': nrm((DEPTH, SHARED_FF, d), SHARED_FF ** -0.5),
    }


def reference(x, c, ctx, c_ctx, ada_w, ada_b, norm_g, w_in, w_out,
              hy_conv_w, hy_conv_b, hy_ffn_w1, hy_ffn_b1, hy_ffn_w2, hy_ffn_b2, hy_ffn_w3, hy_freq, hy_bias, hy_norm,
              hg_lb_logits, hg_norm, gla_a_up, gla_a_b, gla_norm,
              ml_conv_w, ml_conv_b, ml_gate_b, ml_norm,
              router_w, router_b, exp_w_gu, exp_w_down, sh_w_gu, sh_w_down):
    f32 = jnp.float32
    bsz, seq, d = x.shape
    n_ctx = ctx.shape[1]
    rows = seq // GRID_W
    x = x + _pos_embed_2d(rows, d).astype(x.dtype)[None]
    xc = ctx
    lb_cum = jnp.cumsum(jax.nn.softmax(hg_lb_logits.astype(f32), axis=0), axis=0)
    lower_bounds = lb_cum - lb_cum[0:1]
    for l in range(DEPTH):
        with_ctx = l < DEPTH - 1
        mod = (jax.nn.silu(c) @ ada_w[l] + ada_b[l])[:, None, :]
        mod_c = jax.nn.silu(c_ctx) @ ada_w[l] + ada_b[l]
        sh1, sc1, g1, sh2, sc2, g2 = jnp.split(mod, 6, axis=-1)
        csh1, csc1, cg1, csh2, csc2, cg2 = jnp.split(mod_c, 6, axis=-1)
        h = _rms(x, norm_g[l, 0]) * (1.0 + sc1) + sh1
        hc = _rms(xc, norm_g[l, 0]) * (1.0 + csc1) + csh1
        pl = _split((h @ w_in[l]).astype(f32), IN_SPLITS)
        pc = _split((hc @ w_in[l]).astype(f32), IN_SPLITS)
        hy_args = (hy_conv_w[l], hy_conv_b[l], hy_ffn_w1[l], hy_ffn_b1[l], hy_ffn_w2[l], hy_ffn_b2[l],
                   hy_ffn_w3[l], hy_freq[l], hy_bias[l], hy_norm[l])
        y_hy = _hyena(pl[0:3], *hy_args)
        yc_hg, y_hg = _hgrn2(pc[3:8], pl[3:8], lower_bounds[l], hg_norm[l], with_ctx)
        yc_gla, y_gla = _gla(pc[8:14], pl[8:14], gla_a_up[l], gla_a_b[l], gla_norm[l], with_ctx)
        yc_ml, y_ml = _mlstm(pc[14:19], pl[14:19], ml_conv_w[l], ml_conv_b[l], ml_gate_b[l], ml_norm[l], with_ctx)
        y = jnp.concatenate([y_hy, y_hg, y_gla, y_ml], axis=-1).astype(x.dtype) @ w_out[l]
        x = x + g1 * _rms(y, norm_g[l, 1])
        h = _rms(x, norm_g[l, 2]) * (1.0 + sc2) + sh2
        moe_args = (router_w[l], router_b[l], exp_w_gu[l], exp_w_down[l], sh_w_gu[l], sh_w_down[l])
        if with_ctx:
            yc = jnp.concatenate([_hyena(pc[0:3], *hy_args), yc_hg, yc_gla, yc_ml],
                                 axis=-1).astype(xc.dtype) @ w_out[l]
            xc = xc + cg1 * _rms(yc, norm_g[l, 1])
            hc = _rms(xc, norm_g[l, 2]) * (1.0 + csc2) + csh2
            f = _moe(jnp.concatenate([h.reshape(bsz * seq, d), hc.reshape(bsz * n_ctx, d)], axis=0), *moe_args)
            xc = xc + cg2 * _rms(f[bsz * seq:].reshape(bsz, n_ctx, d), norm_g[l, 3])
            f = f[:bsz * seq]
        else:
            f = _moe(h.reshape(bsz * seq, d), *moe_args)
        x = x + g2 * _rms(f.reshape(bsz, seq, d), norm_g[l, 3])
    return x
```

```cpp
#include <hip/hip_runtime.h>
#include <stdint.h>
#include <stdio.h>

#ifndef FUSED
#define FUSED 0
#endif

typedef unsigned short u16;
typedef __attribute__((ext_vector_type(8))) short bf16x8;
typedef __attribute__((ext_vector_type(4))) float f32x4;
typedef float f32x8v __attribute__((ext_vector_type(8)));
typedef float f32x16v __attribute__((ext_vector_type(16)));
typedef __attribute__((ext_vector_type(2))) unsigned u32x2v;
typedef __attribute__((ext_vector_type(16))) unsigned u32x16v;
typedef __attribute__((ext_vector_type(2))) float f32x2v;

#define XB_TMO      128
#define XB_XCNT(j)  (256  + 64 * (j))
#define XB_XSUB(j)  (1280 + 64 * (j))
#define XB_XGEN(j)  (2304 + 64 * (j))
#define XB_TOP      3328
#define XB_TOPGEN   3392
#define XCD_BAR_WORDS 3456
#define XB_SPIN_CAP (1u << 18)
#define LAS __attribute__((address_space(3)))

__device__ __forceinline__ unsigned xb_ld(unsigned* p)              { return __hip_atomic_load(p, __ATOMIC_RELAXED, __HIP_MEMORY_SCOPE_AGENT); }
__device__ __forceinline__ unsigned xb_add(unsigned* p, unsigned v) { return __hip_atomic_fetch_add(p, v, __ATOMIC_RELAXED, __HIP_MEMORY_SCOPE_AGENT); }
__device__ __forceinline__ unsigned xb_xcc_id() { return (unsigned)__builtin_amdgcn_s_getreg((3 << 11) | 20) & 0xFu; }
#define XB_SPIN(cond, bar) do { unsigned _sp = 0; while (cond) { __builtin_amdgcn_s_sleep(1); \
    if ((++_sp & 255u) == 0u) { if (xb_ld(&(bar)[XB_TMO])) break; if (_sp > XB_SPIN_CAP) { atomicAdd(&(bar)[XB_TMO], 1u); break; } } } } while (0)

struct XcdBarrier {
    unsigned* bar; unsigned x;
    volatile LAS unsigned* st;
};

__device__ __forceinline__ XcdBarrier xcd_barrier_post(unsigned* bar, volatile LAS unsigned* st) {
    XcdBarrier b; b.bar = bar; b.x = xb_xcc_id(); b.st = st;
    if (threadIdx.x == 0) (void)xb_add(&bar[XB_XCNT(b.x)], 1u);
    return b;
}
__device__ __forceinline__ void xcd_barrier_complete(unsigned* bar, unsigned x, unsigned& nloc, unsigned& nx) {
    const unsigned G = gridDim.x * gridDim.y * gridDim.z;
    unsigned sum, cnt, mine, sp = 0u;
    for (;;) {
        sum = 0u; cnt = 0u; mine = 0u;
#pragma unroll
        for (unsigned j = 0; j < 16; ++j) { const unsigned c = xb_ld(&bar[XB_XCNT(j)]); sum += c; cnt += (c > 0u) ? 1u : 0u; mine = (j == x) ? c : mine; }
        if (sum == G) break;
        __builtin_amdgcn_s_sleep(1);
        if ((++sp & 255u) == 0u) { if (xb_ld(&bar[XB_TMO])) break; if (sp > XB_SPIN_CAP) { atomicAdd(&bar[XB_TMO], 1u); break; } }
    }
    nloc = mine > 0u ? mine : 1u; nx = cnt > 0u ? cnt : 1u;
}

__device__ __forceinline__ void xcd_barrier(const XcdBarrier& b) {
    asm volatile("s_waitcnt vmcnt(0)" ::: "memory");
    __syncthreads();
    if (threadIdx.x == 0) {
        unsigned* bar = b.bar;
        __builtin_amdgcn_s_waitcnt(0);
        unsigned nloc = b.st[0], nx = b.st[1];
        if (nloc == 0u) { xcd_barrier_complete(bar, b.x, nloc, nx); b.st[0] = nloc; b.st[1] = nx; }
        const unsigned old = xb_add(&bar[XB_XSUB(b.x)], 1u);
        const unsigned gen = old / nloc;
        if (old + 1u == (gen + 1u) * nloc) {
            __builtin_amdgcn_fence(__ATOMIC_RELEASE, "agent");
            asm volatile("s_waitcnt vmcnt(0)" ::: "memory");
            const unsigned og = xb_add(&bar[XB_TOP], 1u);
            const unsigned tg = og / nx;
            if (og + 1u == (tg + 1u) * nx) xb_add(&bar[XB_TOPGEN], 1u);
            else XB_SPIN(xb_ld(&bar[XB_TOPGEN]) == tg, bar);
            __builtin_amdgcn_fence(__ATOMIC_ACQUIRE, "agent");
            xb_add(&bar[XB_XGEN(b.x)], 1u);
            asm volatile("s_waitcnt vmcnt(0)" ::: "memory");
        } else {
            XB_SPIN(xb_ld(&bar[XB_XGEN(b.x)]) == gen, bar);
            __builtin_amdgcn_fence(__ATOMIC_ACQUIRE, "agent");
            asm volatile("s_waitcnt vmcnt(0)" ::: "memory");
        }
    }
    __syncthreads();
}


#define DM 1024
#define SEQL 8192
#define CTXL 256
#define NLAT 16384
#define NCTXR 512
#define NROW 16896
#define DIN 3888
#define NTH 512
#define NCH 132
#define CAP 16896
#define NSLOT (NROW * 8)
#define EPSV 1e-6f

struct Params {
  const float *x, *c, *ctx, *c_ctx, *ada_w, *ada_b, *norm_g, *w_in, *w_out;
  const float *hy_conv_w, *hy_conv_b, *hy_w1, *hy_b1, *hy_w2, *hy_b2, *hy_w3, *hy_freq, *hy_bias, *hy_norm;
  const float *hg_lb_logits, *hg_norm, *gla_a_up, *gla_a_b, *gla_norm;
  const float *ml_conv_w, *ml_conv_b, *ml_gate_b, *ml_norm;
  const float *router_w, *router_b, *exp_w_gu, *exp_w_down, *sh_w_gu, *sh_w_down;
  float* out;
  unsigned* bar;
  u16* X;
  float* MOD;
  float* LBv;
  float* HFT;
  float* HFTC;
  u16* PT;
  uint32_t* HS;
  float2* ZS;
  u16* HN;
  u16* P;
  u16* YMIX;
  float* YO;
  float* HYRAW;
  u16* SBHG;
  u16* SBGL;
  u16* SBML;
  float* NBML;
  float* DCHG;
  float* DCGL;
  float* DCML;
  int* CNT;
  int* WQ;
  int* LTOK;
  float* LW;
  int* TOKSLOT;
  u16* ACT;
  u16* ACTSH;
  u16* FSH;
  u16* YOB;
  u16* YR;
  u16* WinT;
  u16* WoutT;
  u16* ShGuT;
  u16* ShDnT;
  u16* RWT;
  u16* HLO;
  u16* EGU;
  u16* EDN;
};

typedef const __attribute__((address_space(4))) Params& PR;
__device__ __forceinline__ int otid() { int t = threadIdx.x; asm volatile("" : "+v"(t)); return t; }
typedef __bf16 bf16x2_t __attribute__((ext_vector_type(2)));
typedef float float2_t __attribute__((ext_vector_type(2)));
__device__ __forceinline__ uint32_t pk2bf(float a, float b) {
  float2_t v = {a, b};
  bf16x2_t r = __builtin_convertvector(v, bf16x2_t);
  return *(uint32_t*)&r;
}
__device__ __forceinline__ u16 f2bf(float f) { return (u16)(pk2bf(f, 0.f) & 0xFFFFu); }
__device__ __forceinline__ float bf2f(u16 h) { return __uint_as_float(((uint32_t)h) << 16); }
__device__ __forceinline__ float sigmoidf_(float z) { return 1.f / (1.f + expf(-z)); }
__device__ __forceinline__ float siluf_(float z) { return z / (1.f + expf(-z)); }
__device__ __forceinline__ float logsigmoidf_(float z) { return (z >= 0.f) ? -log1pf(expf(-z)) : (z - log1pf(expf(z))); }
__device__ __forceinline__ float fexp(float x) { return __expf(x); }
__device__ __forceinline__ float frcp(float x) { return __builtin_amdgcn_rcpf(x); }
__device__ __forceinline__ float fsigmoid(float z) { return frcp(1.f + __expf(-z)); }
__device__ __forceinline__ float fsilu(float z) { return z * frcp(1.f + __expf(-z)); }
__device__ __forceinline__ float flogsigmoid(float z) { return fminf(z, 0.f) - __logf(1.f + __expf(-fabsf(z))); }
__device__ __forceinline__ int olane() {
  int l = (int)__builtin_amdgcn_mbcnt_hi(~0u, __builtin_amdgcn_mbcnt_lo(~0u, 0u));
  asm volatile("" : "+v"(l));
  return l;
}
__device__ __forceinline__ float shx(float v, int m, int lane) { return __int_as_float(__builtin_amdgcn_ds_bpermute((lane ^ m) << 2, __float_as_int(v))); }
__device__ __forceinline__ int shxi(int v, int m, int lane) { return __builtin_amdgcn_ds_bpermute((lane ^ m) << 2, v); }
__device__ __forceinline__ float shl_(float v, int src) { return __int_as_float(__builtin_amdgcn_ds_bpermute(src << 2, __float_as_int(v))); }
__device__ __forceinline__ float shu(float v, int src) { return __int_as_float(__builtin_amdgcn_readlane(__float_as_int(v), src)); }
template <int CTRL> __device__ __forceinline__ int dppi(int v) { return __builtin_amdgcn_update_dpp(0, v, CTRL, 0xF, 0xF, false); }
template <int CTRL> __device__ __forceinline__ float dppf(float v) {
  return __int_as_float(__builtin_amdgcn_update_dpp(0, __float_as_int(v), CTRL, 0xF, 0xF, false));
}
__device__ __forceinline__ float wave_sum(float v) {
  v += dppf<0xB1>(v);
  v += dppf<0x4E>(v);
  v += dppf<0x141>(v);
  v += dppf<0x140>(v);
  return (shu(v, 0) + shu(v, 16)) + (shu(v, 32) + shu(v, 48));
}
__device__ __forceinline__ float block_sum(float v, float* red) {
  v = wave_sum(v);
  __syncthreads();
  if ((threadIdx.x & 63) == 0) red[threadIdx.x >> 6] = v;
  __syncthreads();
  float s = 0.f;
#pragma unroll
  for (int i = 0; i < 8; ++i) s += red[i];
  return s;
}

#define G2_LD 40
struct GemmSmem { u16 As[2][128 * G2_LD]; u16 Bs[2][256 * G2_LD]; };

template <class BCOL>
__device__ __forceinline__ void gemm_tile(const u16* arow, const float* __restrict__ B, int ldb, const BCOL& bcol, int K,
                                          GemmSmem* sm, f32x4 (&acc)[4][4]) {
  const int tid = otid(), lane = tid & 63, w = tid >> 6, wm = w >> 2, wn = w & 3;
#pragma unroll
  for (int i = 0; i < 4; ++i)
#pragma unroll
    for (int j = 0; j < 4; ++j) acc[i][j] = (f32x4){0.f, 0.f, 0.f, 0.f};
  const int akc = tid & 3, ar = tid >> 2;
  const int kg = tid & 7, ng = tid >> 3;
  const int bc = bcol(ng * 4);
  const float* bp = B + (size_t)(kg * 4) * ldb + bc;
  const u16* ap = arow + akc * 8;
  uint4 ra0, ra1, ra2, ra3;
  float4 rb00, rb01, rb02, rb03, rb10, rb11, rb12, rb13, rb20, rb21, rb22, rb23, rb30, rb31, rb32, rb33;
  const int nk = K >> 5;
#define G2_RB(S, J) rb##S##J
#define G2_LOAD(S, KT)                                                   \
  {                                                                      \
    ra##S = *(const uint4*)(ap + (KT) * 32);                             \
    G2_RB(S, 0) = *(const float4*)(bp + (size_t)((KT) * 32 + 0) * ldb);     \
    G2_RB(S, 1) = *(const float4*)(bp + (size_t)((KT) * 32 + 1) * ldb);     \
    G2_RB(S, 2) = *(const float4*)(bp + (size_t)((KT) * 32 + 2) * ldb);     \
    G2_RB(S, 3) = *(const float4*)(bp + (size_t)((KT) * 32 + 3) * ldb);     \
  }
#define G2_STORE(S, BUF)                                                                                                     \
  {                                                                                                                          \
    *(uint4*)(&sm->As[BUF][ar * G2_LD + akc * 8]) = ra##S;                                                                   \
    *(uint2*)(&sm->Bs[BUF][(ng * 4 + 0) * G2_LD + kg * 4]) = make_uint2(pk2bf(G2_RB(S, 0).x, G2_RB(S, 1).x), pk2bf(G2_RB(S, 2).x, G2_RB(S, 3).x)); \
    *(uint2*)(&sm->Bs[BUF][(ng * 4 + 1) * G2_LD + kg * 4]) = make_uint2(pk2bf(G2_RB(S, 0).y, G2_RB(S, 1).y), pk2bf(G2_RB(S, 2).y, G2_RB(S, 3).y)); \
    *(uint2*)(&sm->Bs[BUF][(ng * 4 + 2) * G2_LD + kg * 4]) = make_uint2(pk2bf(G2_RB(S, 0).z, G2_RB(S, 1).z), pk2bf(G2_RB(S, 2).z, G2_RB(S, 3).z)); \
    *(uint2*)(&sm->Bs[BUF][(ng * 4 + 3) * G2_LD + kg * 4]) = make_uint2(pk2bf(G2_RB(S, 0).w, G2_RB(S, 1).w), pk2bf(G2_RB(S, 2).w, G2_RB(S, 3).w)); \
  }
#define G2_COMPUTE(BUF)                                                                                                      \
  {                                                                                                                          \
    bf16x8 a_[4], b_[4];                                                                                                     \
    _Pragma("unroll") for (int i = 0; i < 4; ++i) a_[i] = *(const bf16x8*)(&sm->As[BUF][(wm * 64 + i * 16 + (lane & 15)) * G2_LD + (lane >> 4) * 8]); \
    _Pragma("unroll") for (int j = 0; j < 4; ++j) b_[j] = *(const bf16x8*)(&sm->Bs[BUF][(wn * 64 + j * 16 + (lane & 15)) * G2_LD + (lane >> 4) * 8]); \
    _Pragma("unroll") for (int i = 0; i < 4; ++i)                                                                            \
      _Pragma("unroll") for (int j = 0; j < 4; ++j) acc[i][j] = __builtin_amdgcn_mfma_f32_16x16x32_bf16(a_[i], b_[j], acc[i][j], 0, 0, 0); \
  }
#define G2_STEP(U, UN, BUF, BUFN)                      \
  {                                                    \
    const int kt = kt0 + U;                            \
    if (kt + 4 < nk) G2_LOAD(U, kt + 4)                \
    G2_COMPUTE(BUF)                                    \
    if (kt + 1 < nk) G2_STORE(UN, BUFN)                \
    __syncthreads();                                   \
  }
  G2_LOAD(0, 0) G2_LOAD(1, 1) G2_LOAD(2, 2) G2_LOAD(3, 3)
  __syncthreads();
  G2_STORE(0, 0)
  __syncthreads();
  for (int kt0 = 0; kt0 < nk; kt0 += 4) {
    G2_STEP(0, 1, 0, 1)
    G2_STEP(1, 2, 1, 0)
    G2_STEP(2, 3, 0, 1)
    G2_STEP(3, 0, 1, 0)
  }
#undef G2_LOAD
#undef G2_RB
#undef G2_STORE
#undef G2_COMPUTE
#undef G2_STEP
}

#define XINFO_OFF (16384 * 8 + 256 * 8 + 64 + 16)
#define XCEN_WORD 3600
struct TileIter {
  int G, cs, nx, xo, rk, round;
  __device__ __forceinline__ TileIter() : G(gridDim.x), round(0) {
    extern __shared__ __align__(16) unsigned char smem_ti[];
    const int* xi = (const int*)(smem_ti + XINFO_OFF);
    xo = __builtin_amdgcn_readfirstlane(xi[0]); rk = __builtin_amdgcn_readfirstlane(xi[1]);
    cs = __builtin_amdgcn_readfirstlane(xi[2]); nx = __builtin_amdgcn_readfirstlane(xi[3]);
  }
  __device__ __forceinline__ int next(int ntiles) { return __builtin_amdgcn_readfirstlane(next_(ntiles)); }
  __device__ __forceinline__ int next_(int ntiles) {
    for (;;) {
      if (cs == 0) { const int t = blockIdx.x + round * G; ++round; return t < ntiles ? t : -1; }
      const int chunk = round * nx + xo;
      ++round;
      if (chunk * cs >= ntiles) {
        if ((round - 1) * nx * cs >= ntiles) return -1;
        continue;
      }
      const int t = chunk * cs + rk;
      if (t < ntiles) return t;
    }
  }
};

#define G8_HT (128 * 64)
__device__ __forceinline__ int g8_lds_byte(int r, int c) {
  int st = (r >> 4) * 2 + (c >> 5), rr = r & 15, cc = c & 31, ob = rr * 64 + cc * 2;
  return st * 1024 + (ob ^ (((ob >> 9) & 1) << 5));
}
__device__ __forceinline__ void g8_stage_rc(int b, int& R, int& C) {
  int st = b / 1024, sb = b % 1024, swz = sb ^ (((sb >> 9) & 1) << 5);
  R = (st >> 1) * 16 + swz / 64; C = (st & 1) * 32 + (swz % 64) / 2;
}
template <bool PAIR, bool GATHER, int STG, class EPI>
__device__ __forceinline__ void gemm256(const u16* A, const u16* A2, int kswitch, int lda, const u16* Bt, int K, int brow, int bcol,
                                        unsigned char* smem, const EPI& epi, const int* rowtab = nullptr, int nvalid = 256, int nvalidB = 256) {
  const int amask = (lda >> 6) - 1;
  const bool hiv = nvalid > 128;
  const bool hjv = nvalidB > 128;
  int go00 = 0, go01 = 0, go10 = 0, go11 = 0;
  if (GATHER) {
    const int t0 = otid();
    int r0_, r1_, c_;
    g8_stage_rc(t0 * 16, r0_, c_);
    g8_stage_rc(t0 * 16 + 8192, r1_, c_);
    go00 = rowtab[(r0_ < nvalid) ? r0_ : 0] * lda;
    go01 = rowtab[(r1_ < nvalid) ? r1_ : 0] * lda;
    go10 = rowtab[(128 + r0_ < nvalid) ? 128 + r0_ : 0] * lda;
    go11 = rowtab[(128 + r1_ < nvalid) ? 128 + r1_ : 0] * lda;
  }
  u16* shm = (u16*)smem;
#define G8_SA(b, h) (shm + ((b) * 2 + (h)) * G8_HT)
#define G8_SB(b, h) (shm + (4 + (b) * 2 + (h)) * G8_HT)
#define G8_STAGE_B(T, P, BASE, br, kt) do { long _g = (long)(br) * K + (long)(kt) * 64; \
    for (int _i = 0; _i < 2; ++_i) { int _b = (T) * 16 + _i * 8192; int _r, _c; g8_stage_rc(_b, _r, _c); \
      __builtin_amdgcn_global_load_lds((const unsigned*)(BASE + _g + (long)_r * K + _c), \
        (LAS unsigned*)((char*)(P) + _b), 16, 0, 0); } } while (0)
#define G8_STAGE_A(T, P, BASE, br, kt) do { const u16* _ab = ((kt) < kswitch) ? A : A2; long _g = (long)((kt) & amask) * 64; \
    const int _h = ((br) - brow) >> 7; \
    for (int _i = 0; _i < 2; ++_i) { int _b = (T) * 16 + _i * 8192; int _r, _c; g8_stage_rc(_b, _r, _c); \
      const long _ro = GATHER ? (long)(_h == 0 ? (_i == 0 ? go00 : go01) : (_i == 0 ? go10 : go11)) : ((long)(br) + _r) * lda; \
      __builtin_amdgcn_global_load_lds((const unsigned*)(_ab + _g + _ro + _c), \
        (LAS unsigned*)((char*)(P) + _b), 16, 0, 0); } } while (0)
#define G8_STAGE_X(T, P, BASE, br, kt) G8_STAGE_##BASE(T, P, BASE, br, kt)
#define G8_STAGE_Bt G8_STAGE_B
#define G8_STAGE(P, BASE, br, kt) G8_STAGE_X(tx, P, BASE, br, kt)
#define G8_LDA(dst, b, h) for (int m = 0; m < 4; ++m) for (int k = 0; k < 2; ++k) \
    dst[m][k] = *reinterpret_cast<const bf16x8*>((char*)G8_SA(b, h) + g8_lds_byte(wr * 64 + m * 16 + fr, k * 32 + fq * 8))
#define G8_LDB(dst, b, h) for (int n = 0; n < 2; ++n) for (int k = 0; k < 2; ++k) \
    dst[n][k] = *reinterpret_cast<const bf16x8*>((char*)G8_SB(b, h) + g8_lds_byte(wc * 32 + n * 16 + fr, k * 32 + fq * 8))
#define G8_MMA(ai, bj, At, Bt_) do { __builtin_amdgcn_s_setprio(1); \
    for (int m = 0; m < 4; ++m) for (int n = 0; n < 2; ++n) for (int k = 0; k < 2; ++k) \
      acc[ai][bj][m][n] = __builtin_amdgcn_mfma_f32_16x16x32_bf16(At[m][k], Bt_[n][k], acc[ai][bj][m][n], 0, 0, 0); \
    __builtin_amdgcn_s_setprio(0); } while (0)
#define G8_WAIT_V(n) asm volatile("s_waitcnt vmcnt(" #n ")" ::: "memory")
#define G8_WAIT_L(n) asm volatile("s_waitcnt lgkmcnt(" #n ")" ::: "memory")
#define G8_BAR __builtin_amdgcn_s_barrier()
#define G8_SCHED __builtin_amdgcn_sched_barrier(0)
  int tx = otid();
  int wid = tx >> 6, lane = tx & 63, wr = wid >> 2, wc = wid & 3, fr = lane & 15, fq = lane >> 4;
  f32x4 acc[2][2][4][2] = {};
  bf16x8 At[4][2], B0[2][2], B1[2][2];
  const int nt = K / 64;
  G8_WAIT_V(0); G8_WAIT_L(0);
  __syncthreads();
  G8_STAGE(G8_SB(0, 0), Bt, bcol, 0); G8_STAGE(G8_SA(0, 0), A, brow, 0);
  G8_STAGE(G8_SB(0, 1), Bt, bcol + 128, 0); G8_STAGE(G8_SA(0, 1), A, brow + 128, 0);
  if (wr == 1) G8_BAR;
  G8_WAIT_V(4); G8_BAR;
  G8_STAGE(G8_SB(1, 0), Bt, bcol, 1); G8_STAGE(G8_SA(1, 0), A, brow, 1); G8_STAGE(G8_SB(1, 1), Bt, bcol + 128, 1);
  G8_WAIT_V(6); G8_BAR;
  for (int t = 0; t < nt - 2; t += 2) {
    G8_LDB(B0, 0, 0); G8_SCHED; G8_LDA(At, 0, 0); G8_STAGE(G8_SA(1, 1), A, brow + 128, t + 1);
    G8_WAIT_L(8); G8_BAR; G8_WAIT_L(0); G8_MMA(0, 0, At, B0); G8_BAR; G8_SCHED;
    G8_LDB(B1, 0, 1); G8_STAGE(G8_SB(0, 0), Bt, bcol, t + 2);
    G8_BAR; G8_WAIT_L(0); if (hjv) G8_MMA(0, 1, At, B1); G8_BAR;
    G8_LDA(At, 0, 1); G8_STAGE(G8_SA(0, 0), A, brow, t + 2);
    G8_BAR; G8_WAIT_L(0); if (hiv) G8_MMA(1, 0, At, B0); G8_BAR; G8_SCHED;
    G8_STAGE(G8_SB(0, 1), Bt, bcol + 128, t + 2);
    G8_WAIT_V(6); G8_BAR; if (hiv && hjv) G8_MMA(1, 1, At, B1); G8_BAR;
    G8_LDB(B0, 1, 0); G8_SCHED; G8_LDA(At, 1, 0); G8_STAGE(G8_SA(0, 1), A, brow + 128, t + 2);
    G8_WAIT_L(8); G8_BAR; G8_WAIT_L(0); G8_MMA(0, 0, At, B0); G8_BAR; G8_SCHED;
    G8_LDB(B1, 1, 1); G8_STAGE(G8_SB(1, 0), Bt, bcol, t + 3);
    G8_BAR; G8_WAIT_L(0); if (hjv) G8_MMA(0, 1, At, B1); G8_BAR;
    G8_LDA(At, 1, 1); G8_STAGE(G8_SA(1, 0), A, brow, t + 3);
    G8_BAR; G8_WAIT_L(0); if (hiv) G8_MMA(1, 0, At, B0); G8_BAR; G8_SCHED;
    G8_STAGE(G8_SB(1, 1), Bt, bcol + 128, t + 3);
    G8_WAIT_V(6); G8_BAR; if (hiv && hjv) G8_MMA(1, 1, At, B1); G8_BAR;
  }
  int tz = otid(); wid = tz >> 6; lane = tz & 63; wr = wid >> 2; wc = wid & 3; fr = lane & 15; fq = lane >> 4;
  { G8_LDB(B0, 0, 0); G8_WAIT_V(0); G8_LDA(At, 0, 0); G8_STAGE_X(tz, G8_SA(1, 1), A, brow + 128, nt - 1);
    G8_BAR; G8_WAIT_L(0); G8_MMA(0, 0, At, B0); G8_BAR;
    G8_LDB(B1, 0, 1); G8_BAR; G8_WAIT_L(0); if (hjv) G8_MMA(0, 1, At, B1); G8_BAR;
    G8_LDA(At, 0, 1); G8_WAIT_V(4); G8_BAR; G8_WAIT_L(0); if (hiv) G8_MMA(1, 0, At, B0); if (hiv && hjv) G8_MMA(1, 1, At, B1); G8_BAR; }
  { G8_LDB(B0, 1, 0); G8_LDA(At, 1, 0); G8_WAIT_V(2); G8_BAR; G8_WAIT_L(0); G8_MMA(0, 0, At, B0); G8_BAR;
    G8_LDB(B1, 1, 1); G8_WAIT_V(0); G8_BAR; G8_WAIT_L(0); if (hjv) G8_MMA(0, 1, At, B1); G8_BAR;
    G8_LDA(At, 1, 1); G8_BAR; G8_WAIT_L(0); if (hiv) G8_MMA(1, 0, At, B0); if (hiv && hjv) G8_MMA(1, 1, At, B1); G8_BAR; }
  if (wr == 0) G8_BAR;
  if constexpr (STG == 0) {
#pragma unroll
    for (int ai = 0; ai < 2; ++ai)
#pragma unroll
      for (int bj = 0; bj < 2; ++bj)
#pragma unroll
        for (int m = 0; m < 4; ++m) {
          const int row0 = brow + ai * 128 + wr * 64 + m * 16 + fq * 4, col = bcol + bj * 128 + wc * 32 + fr;
          if constexpr (PAIR) epi(row0, col, acc[ai][bj][m][0], acc[ai][bj][m][1]);
          else { epi(row0, col, acc[ai][bj][m][0], acc[ai][bj][m][0]); epi(row0, col + 16, acc[ai][bj][m][1], acc[ai][bj][m][1]); }
        }
  } else {
    float* T = (float*)smem;
#pragma unroll
    for (int ai = 0; ai < 2; ++ai) {
      if (ai == 1 && !hiv) break;
      __syncthreads();
#pragma unroll
      for (int bj = 0; bj < 2; ++bj)
#pragma unroll
        for (int m = 0; m < 4; ++m)
#pragma unroll
          for (int n = 0; n < 2; ++n)
#pragma unroll
            for (int r = 0; r < 4; ++r) {
              const int row = wr * 64 + m * 16 + fq * 4 + r, col = bj * 128 + wc * 32 + n * 16 + fr;
              T[row * 256 + (col ^ ((fq & 1) << 4))] = acc[ai][bj][m][n][r];
            }
      __syncthreads();
      if constexpr (!PAIR) {
#pragma unroll 4
        for (int i = 0; i < 16; ++i) {
          const int row = wid + 8 * i;
          const float4 v = *(const float4*)(T + row * 256 + ((lane * 4) ^ (((row >> 2) & 1) << 4)));
          epi(brow + ai * 128 + row, bcol + lane * 4, v, v);
        }
      } else {
#pragma unroll 4
        for (int i = 0; i < 8; ++i) {
          const int row = wid * 2 + (lane >> 5) + 16 * i;
          const int j = lane & 31, blk = j >> 2, q = j & 3;
          const int sw = ((row >> 2) & 1) << 4;
          const float4 vg = *(const float4*)(T + row * 256 + ((blk * 32 + q * 4) ^ sw));
          const float4 vu = *(const float4*)(T + row * 256 + ((blk * 32 + 16 + q * 4) ^ sw));
          epi(brow + ai * 128 + row, (bcol >> 1) + blk * 16 + q * 4, vg, vu);
        }
      }
    }
  }
#undef G8_SA
#undef G8_SB
#undef G8_STAGE_X
#undef G8_STAGE_A
#undef G8_STAGE_B
#undef G8_STAGE_Bt
#undef G8_STAGE
#undef G8_LDA
#undef G8_LDB
#undef G8_MMA
#undef G8_WAIT_V
#undef G8_WAIT_L
#undef G8_BAR
#undef G8_SCHED
}
__device__ __forceinline__ void g8_tile(int t, int nM, int nN, int& pm, int& pn) {
  const int nig = 8 * nN, gid = t / nig, fm = gid * 8, gsz = min(nM - fm, 8);
  pm = fm + ((t % nig) % gsz); pn = (t % nig) / gsz;
}

__device__ __forceinline__ void phase_prologue(PR p, unsigned char* smem) {
  const int tid = otid();
  float* fs = (float*)smem;
  {
    const int j = tid & 255, qh = tid >> 8;
    const float omega = exp2f(-(float)j * (13.287712379549449f / 256.0f));
    for (int r0 = blockIdx.x; r0 < NROW; r0 += 4 * gridDim.x) {
      float va[4], vb[4];
#pragma unroll
      for (int u = 0; u < 4; ++u) {
        const int r = min(r0 + u * (int)gridDim.x, NROW - 1);
        const float* src = (r < NLAT) ? p.x + (size_t)r * DM : p.ctx + (size_t)(r - NLAT) * DM;
        va[u] = __builtin_nontemporal_load(src + tid);
        vb[u] = __builtin_nontemporal_load(src + 512 + tid);
      }
#pragma unroll
      for (int u = 0; u < 4; ++u) {
        const int r = r0 + u * (int)gridDim.x;
        if (r < NROW) {
          float a = va[u], b = vb[u];
          if (r < NLAT) {
            const int t = r & (SEQL - 1);
            const float a0 = (float)(t >> 6) * omega, a1 = (float)(t & 63) * omega;
            a += qh ? __cosf(a0) : __sinf(a0);
            b += qh ? __cosf(a1) : __sinf(a1);
          }
          p.X[(size_t)r * DM + tid] = f2bf(a);
          p.X[(size_t)r * DM + 512 + tid] = f2bf(b);
        }
      }
    }
  }
  for (int it = blockIdx.x; it < 192; it += gridDim.x) {
    const int l = it / 96, n0 = (it % 96) * 64;
    __syncthreads();
    for (int e = tid; e < 3 * DM; e += NTH) {
      const int j = e >> 10, k = e & 1023;
      const float cv = (j < 2) ? p.c[j * DM + k] : p.c_ctx[k];
      fs[e] = siluf_(cv);
    }
    __syncthreads();
    const int n4 = tid & 15, ks = tid >> 4;
    float4 a0 = make_float4(0.f, 0.f, 0.f, 0.f), a1 = a0, a2 = a0;
    const float* W = p.ada_w + (size_t)l * DM * 6144 + n0 + n4 * 4;
#pragma unroll 8
    for (int k = ks * 32; k < ks * 32 + 32; ++k) {
      const f32x4 wv_ = __builtin_nontemporal_load((const f32x4*)(W + (size_t)k * 6144));
      const float4 wv = make_float4(wv_[0], wv_[1], wv_[2], wv_[3]);
      const float c0 = fs[k], c1 = fs[1024 + k], c2 = fs[2048 + k];
      a0.x += c0 * wv.x; a0.y += c0 * wv.y; a0.z += c0 * wv.z; a0.w += c0 * wv.w;
      a1.x += c1 * wv.x; a1.y += c1 * wv.y; a1.z += c1 * wv.z; a1.w += c1 * wv.w;
      a2.x += c2 * wv.x; a2.y += c2 * wv.y; a2.z += c2 * wv.z; a2.w += c2 * wv.w;
    }
    float* red = fs + 3 * DM;
    *(float4*)(red + (ks * 3 + 0) * 64 + n4 * 4) = a0;
    *(float4*)(red + (ks * 3 + 1) * 64 + n4 * 4) = a1;
    *(float4*)(red + (ks * 3 + 2) * 64 + n4 * 4) = a2;
    __syncthreads();
    if (tid < 192) {
      const int j = tid >> 6, nn = tid & 63;
      float s = p.ada_b[l * 6144 + n0 + nn];
#pragma unroll
      for (int q = 0; q < 32; ++q) s += red[(q * 3 + j) * 64 + nn];
      p.MOD[(l * 3 + j) * 6144 + n0 + nn] = s;
    }
  }
  if (blockIdx.x == 0) {
    if (tid < 256) {
      const float a = p.hg_lb_logits[tid], b = p.hg_lb_logits[256 + tid];
      const float m = fmaxf(a, b);
      const float ea = expf(a - m), eb = expf(b - m);
      p.LBv[tid] = 0.f;
      p.LBv[256 + tid] = eb / (ea + eb);
    }
    p.CNT[tid] = 0;
    if (tid < 8) p.WQ[tid] = 0;
  }
  {
    const int lane = tid & 63, w = tid >> 6;
    float* zs = fs;
    const int rot = ((int)blockIdx.x + (int)gridDim.x - (192 % (int)gridDim.x)) % (int)gridDim.x;
    for (int pass = 0; pass < 2; ++pass)
    for (int it = pass ? 256 + rot : (int)blockIdx.x; it < (pass ? 272 : 256); it += gridDim.x) {
      const bool isc = it >= 256;
      const int l = isc ? 0 : it >> 7;
      const int nlg = isc ? 1 : 4;
      const int lag0 = isc ? (it - 256) * 16 : (it & 127) * 64;
      const int L = isc ? 256 : 8192;
      __syncthreads();
      for (int q = 0; q < 2 * nlg; ++q) {
        const int i = lag0 + w * 2 * nlg + q;
        const float tt = (float)i / (float)(L - 1);
        const float wv = 6.283185307179586f * (float)i / (float)L;
        float feat = 0.f;
        if (lane == 0) feat = tt;
        else if (lane < 33) {
          const int jb = (lane - 1) & 15;
          const float band = 1e-4f + (float)jb * ((15.0f - 1e-4f) / 15.0f);
          const float ang = band * wv;
          feat = (lane <= 16) ? cosf(ang) : -sinf(ang);
        }
        float a = p.hy_b1[l * 64 + lane];
        for (int j = 0; j < 33; ++j) a += shu(feat, j) * p.hy_w1[(l * 33 + j) * 64 + lane];
        const float z1 = sinf(p.hy_freq[(l * 2 + 0) * 64 + lane] * a);
        float a2 = p.hy_b2[l * 64 + lane];
        for (int j = 0; j < 64; ++j) a2 += shu(z1, j) * p.hy_w2[(l * 64 + j) * 64 + lane];
        zs[(w * 2 * nlg + q) * 65 + lane] = sinf(p.hy_freq[(l * 2 + 1) * 64 + lane] * a2);
      }
      __syncthreads();
      const float* w3 = p.hy_w3 + (size_t)l * 64 * 1024;
      const int fr = lane & 15, fk = lane >> 4;
#pragma unroll 1
      for (int nh = 0; nh < 2; ++nh) {
        f32x4 c00 = {0.f, 0.f, 0.f, 0.f}, c01 = c00, c02 = c00, c03 = c00, c10 = c00, c11 = c00, c12 = c00, c13 = c00,
              c20 = c00, c21 = c00, c22 = c00, c23 = c00, c30 = c00, c31 = c00, c32 = c00, c33 = c00;
        const float* wb = w3 + (size_t)fk * 1024 + w * 128 + nh * 64 + fr;
        const float* za = zs + fr * 65 + fk;
#pragma unroll 4
        for (int ks = 0; ks < 16; ++ks) {
          const float b0 = wb[(size_t)ks * 4096], b1 = wb[(size_t)ks * 4096 + 16], b2 = wb[(size_t)ks * 4096 + 32], b3 = wb[(size_t)ks * 4096 + 48];
          const float a0 = za[ks * 4], a1 = za[16 * 65 + ks * 4], a2 = za[32 * 65 + ks * 4], a3 = za[48 * 65 + ks * 4];
#define HF_MMA(C, A_, B_) C = __builtin_amdgcn_mfma_f32_16x16x4f32(A_, B_, C, 0, 0, 0)
          HF_MMA(c00, a0, b0); HF_MMA(c01, a0, b1); HF_MMA(c02, a0, b2); HF_MMA(c03, a0, b3);
          HF_MMA(c10, a1, b0); HF_MMA(c11, a1, b1); HF_MMA(c12, a1, b2); HF_MMA(c13, a1, b3);
          HF_MMA(c20, a2, b0); HF_MMA(c21, a2, b1); HF_MMA(c22, a2, b2); HF_MMA(c23, a2, b3);
          HF_MMA(c30, a3, b0); HF_MMA(c31, a3, b1); HF_MMA(c32, a3, b2); HF_MMA(c33, a3, b3);
#undef HF_MMA
        }
#define HF_ST(C, LB, NB) if ((LB) < nlg) { const int n_ = w * 128 + nh * 64 + (NB) * 16 + fr; const int lg_ = lag0 + (LB) * 16 + fk * 4; \
          float* o_ = isc ? p.HFTC + (size_t)n_ * 256 + lg_ : p.HFT + ((size_t)l * 1024 + n_) * 8192 + lg_; \
          *(float4*)o_ = make_float4(C[0], C[1], C[2], C[3]); }
        HF_ST(c00, 0, 0) HF_ST(c01, 0, 1) HF_ST(c02, 0, 2) HF_ST(c03, 0, 3)
        HF_ST(c10, 1, 0) HF_ST(c11, 1, 1) HF_ST(c12, 1, 2) HF_ST(c13, 1, 3)
        HF_ST(c20, 2, 0) HF_ST(c21, 2, 1) HF_ST(c22, 2, 2) HF_ST(c23, 2, 3)
        HF_ST(c30, 3, 0) HF_ST(c31, 3, 1) HF_ST(c32, 3, 2) HF_ST(c33, 3, 3)
#undef HF_ST
      }
    }
  }
  {
    const int gt = blockIdx.x * NTH + tid, ntot = gridDim.x * NTH;
    const int n0c = 2 * 4096 * 128, n1c = 2 * 1024 * 128, n2c = 2 * 512 * 128, n3c = 2 * 1024 * 32, n4c = 2 * 256 * 384;
    for (int e = gt; e < n0c + n1c + n2c + n3c + n4c; e += ntot) {
      const float* src; u16* dst; int n, kc, K, lds_, col; int lo = 0; int kcs;
      bool zero = false;
      if (e < n0c) { const int l = e / (4096 * 128), q = e % (4096 * 128); n = q % 4096; kc = q / 4096; K = 1024; lds_ = DIN; col = (n < DIN) ? n : 0; zero = n >= DIN;
        src = p.w_in + (size_t)l * DM * DIN; dst = p.WinT + (size_t)l * 4096 * 1024; }
      else if (e < n0c + n1c) { const int q0 = e - n0c; const int l = q0 / (1024 * 128), q = q0 % (1024 * 128); n = q % 1024; kc = q / 1024; K = 1024; lds_ = DM; col = n;
        src = p.w_out + (size_t)l * DM * DM; dst = p.WoutT + (size_t)l * 1024 * 1024; }
      else if (e < n0c + n1c + n2c) { const int q0 = e - n0c - n1c; const int l = q0 / (512 * 128), q = q0 % (512 * 128); n = q % 512; kc = q / 512; K = 1024; lds_ = 512;
        col = ((n & 31) < 16) ? ((n >> 5) * 16 + (n & 15)) : (256 + (n >> 5) * 16 + (n & 15));
        src = p.sh_w_gu + (size_t)l * DM * 512; dst = p.ShGuT + (size_t)l * 512 * 1024; }
      else if (e < n0c + n1c + n2c + n3c) { const int q0 = e - n0c - n1c - n2c; const int l = q0 / (1024 * 32), q = q0 % (1024 * 32); n = q % 1024; kc = q / 1024; K = 256; lds_ = DM; col = n;
        src = p.sh_w_down + (size_t)l * 256 * DM; dst = p.ShDnT + (size_t)l * 1024 * 256; }
      else { const int q0 = e - n0c - n1c - n2c - n3c; const int l = q0 / (256 * 384), q = q0 % (256 * 384); n = q % 256; kc = q / 256; K = 3072; lds_ = 256; col = n;
        lo = (kc >= 128 && kc < 256) ? 1 : 0;
        src = p.router_w + (size_t)l * DM * 256; dst = p.RWT + (size_t)l * 256 * 3072; }
      kcs = (K == 3072) ? (kc & 127) : kc;
      const float* sp = src + (size_t)(kcs * 8) * lds_ + col;
#define NTF(P_) __builtin_nontemporal_load(P_)
      float f0 = NTF(sp), f1 = NTF(sp + (size_t)lds_), f2 = NTF(sp + (size_t)2 * lds_), f3 = NTF(sp + (size_t)3 * lds_);
      float f4 = NTF(sp + (size_t)4 * lds_), f5 = NTF(sp + (size_t)5 * lds_), f6 = NTF(sp + (size_t)6 * lds_), f7 = NTF(sp + (size_t)7 * lds_);
#undef NTF
      if (lo) {
        f0 -= bf2f(f2bf(f0)); f1 -= bf2f(f2bf(f1)); f2 -= bf2f(f2bf(f2)); f3 -= bf2f(f2bf(f3));
        f4 -= bf2f(f2bf(f4)); f5 -= bf2f(f2bf(f5)); f6 -= bf2f(f2bf(f6)); f7 -= bf2f(f2bf(f7));
      }
      uint4 o;
      o.x = pk2bf(f0, f1);
      o.y = pk2bf(f2, f3);
      o.z = pk2bf(f4, f5);
      o.w = pk2bf(f6, f7);
      if (zero) o = make_uint4(0u, 0u, 0u, 0u);
      *(uint4*)(dst + (size_t)n * K + kc * 8) = o;
    }
  }
}

__device__ __forceinline__ float4 ldx4(const u16* q) {
  const uint2 t = *(const uint2*)q;
  return make_float4(bf2f((u16)(t.x & 0xFFFF)), bf2f((u16)(t.x >> 16)), bf2f((u16)(t.y & 0xFFFF)), bf2f((u16)(t.y >> 16)));
}
__device__ __forceinline__ void stx4(u16* q, const float4& v) { *(uint2*)q = make_uint2(pk2bf(v.x, v.y), pk2bf(v.z, v.w)); }
__device__ __forceinline__ int mod_index(int r) { return r < NLAT ? (r >> 13) : 2; }

__device__ __forceinline__ void phase_norm1(PR p, int l) {
  const int tid_ = otid();
  const int lane = tid_ & 63;
  const int gw = blockIdx.x * 8 + (tid_ >> 6), nw = gridDim.x * 8;
  const float* g = p.norm_g + (l * 4 + 0) * DM;
  for (int r = gw; r < NROW; r += nw) {
    const float* mod = p.MOD + (l * 3 + mod_index(r)) * 6144;
    float4 xv[4];
    float ss = 0.f;
#pragma unroll
    for (int q = 0; q < 4; ++q) {
      xv[q] = ldx4(p.X + (size_t)r * DM + q * 256 + lane * 4);
      ss += xv[q].x * xv[q].x + xv[q].y * xv[q].y + xv[q].z * xv[q].z + xv[q].w * xv[q].w;
    }
    ss = wave_sum(ss);
    const float rs = rsqrtf(ss * (1.f / DM) + EPSV);
#pragma unroll
    for (int q = 0; q < 4; ++q) {
      const int e = q * 256 + lane * 4;
      const float4 gv = *(const float4*)(g + e);
      const float4 sh = *(const float4*)(mod + e);
      const float4 sc = *(const float4*)(mod + 1024 + e);
      uint2 o;
      o.x = (uint32_t)f2bf(xv[q].x * rs * gv.x * (1.f + sc.x) + sh.x) | ((uint32_t)f2bf(xv[q].y * rs * gv.y * (1.f + sc.y) + sh.y) << 16);
      o.y = (uint32_t)f2bf(xv[q].z * rs * gv.z * (1.f + sc.z) + sh.z) | ((uint32_t)f2bf(xv[q].w * rs * gv.w * (1.f + sc.w) + sh.w) << 16);
      *(uint2*)(p.HN + (size_t)r * DM + e) = o;
    }
  }
}

__device__ __forceinline__ void phase_inproj(PR p, int l, unsigned char* smem) {
  const int NFULL = 66 * 15, NTAIL = 66;
  u16* P_ = p.P; u16* PT_ = p.PT;
  const u16* Wt = p.WinT + (size_t)l * 4096 * 1024;
  TileIter ti;
  for (int it = ti.next(NFULL + NTAIL); it >= 0; it = ti.next(NFULL + NTAIL)) {
    if (it < NFULL) {
      int pm, pn;
      g8_tile(it, 66, 15, pm, pn);
      if (pn < 3)
        gemm256<false, false, 0>(p.HN, p.HN, 1 << 30, DM, Wt, DM, pm * 256, pn * 256, smem,
                       [&](int row0, int col, const f32x4& v, const f32x4&) {
                         *(uint2*)(PT_ + (size_t)col * NROW + row0) = make_uint2(pk2bf(v[0], v[1]), pk2bf(v[2], v[3]));
                       });
      else
        gemm256<false, false, 1>(p.HN, p.HN, 1 << 30, DM, Wt, DM, pm * 256, pn * 256, smem,
                       [&](int row, int col, const float4& v, const float4&) { *(uint2*)(P_ + (size_t)row * DIN + col) = make_uint2(pk2bf(v.x, v.y), pk2bf(v.z, v.w)); });
    } else {
      const int pm = it - NFULL;
      gemm256<false, false, 1>(p.HN, p.HN, 1 << 30, DM, Wt, DM, pm * 256, 3840, smem,
                     [&](int row, int col, const float4& v, const float4&) { if (col < DIN) *(uint2*)(P_ + (size_t)row * DIN + col) = make_uint2(pk2bf(v.x, v.y), pk2bf(v.z, v.w)); },
                     nullptr, 256, 48);
    }
  }
}

__device__ __forceinline__ int lat_row(int b, int t) { return b * SEQL + t; }
__device__ __forceinline__ int ctx_row(int b, int t) { return NLAT + b * CTXL + t; }

__device__ __forceinline__ float hy_sconv(PR p, int l, int rowbase, int t, int L, int ch) {
  const float* cw = p.hy_conv_w + (size_t)l * 3 * 768;
  float a = p.hy_conv_b[l * 768 + ch];
  const u16* Pc = p.PT + (size_t)ch * NROW + rowbase + t;
  if (t > 0) a += bf2f(Pc[-1]) * cw[ch];
  a += bf2f(Pc[0]) * cw[768 + ch];
  if (t < L - 1) a += bf2f(Pc[1]) * cw[2 * 768 + ch];
  return a;
}

#define HY_MIN_DECAY (-3.0701134573253944f)
#define HY_MAX_DECAY (-15.350567286626972f)

__device__ __forceinline__ float2 cmul(float2 a, float2 b) { return make_float2(a.x * b.x - a.y * b.y, a.x * b.y + a.y * b.x); }
__device__ __forceinline__ float2 cmulc(float2 a, float2 b) { return make_float2(a.x * b.x + a.y * b.y, a.y * b.x - a.x * b.y); }

template <bool INV, int S, int BATCH>
__device__ __forceinline__ void fft16k_stage(float2* X, const float2* twh, const float2* twl, int tid) {
  constexpr int Lq = 4096 >> (2 * S);
  constexpr int tsh = 2 * S;
#pragma unroll
  for (int g = 0; g < 8 / BATCH; ++g) {
    float2 a0[BATCH], a1[BATCH], a2[BATCH], a3[BATCH], w1[BATCH];
#pragma unroll
    for (int u = 0; u < BATCH; ++u) {
      const int bidx = tid + NTH * (g * BATCH + u);
      const int j = bidx & (Lq - 1);
      const float2* ptr = X + ((bidx - j) << 2) + j;
      a0[u] = ptr[0]; a1[u] = ptr[Lq]; a2[u] = ptr[2 * Lq]; a3[u] = ptr[3 * Lq];
      const int e1 = j << tsh;
      w1[u] = cmul(twh[e1 >> 7], twl[e1 & 127]);
    }
#pragma unroll
    for (int u = 0; u < BATCH; ++u) {
      const int bidx = tid + NTH * (g * BATCH + u);
      const int j = bidx & (Lq - 1);
      float2* ptr = X + ((bidx - j) << 2) + j;
      const float2 w2 = cmul(w1[u], w1[u]), w3 = cmul(w2, w1[u]);
      if (!INV) {
        const float2 b0 = make_float2(a0[u].x + a2[u].x, a0[u].y + a2[u].y), b1 = make_float2(a0[u].x - a2[u].x, a0[u].y - a2[u].y);
        const float2 b2 = make_float2(a1[u].x + a3[u].x, a1[u].y + a3[u].y), d = make_float2(a1[u].x - a3[u].x, a1[u].y - a3[u].y);
        const float2 b3 = make_float2(d.y, -d.x);
        ptr[0] = make_float2(b0.x + b2.x, b0.y + b2.y);
        ptr[Lq] = cmul(make_float2(b1.x + b3.x, b1.y + b3.y), w1[u]);
        ptr[2 * Lq] = cmul(make_float2(b0.x - b2.x, b0.y - b2.y), w2);
        ptr[3 * Lq] = cmul(make_float2(b1.x - b3.x, b1.y - b3.y), w3);
      } else {
        const float2 y0 = a0[u], y1 = cmulc(a1[u], w1[u]), y2 = cmulc(a2[u], w2), y3 = cmulc(a3[u], w3);
        const float2 b0 = make_float2(y0.x + y2.x, y0.y + y2.y), b1 = make_float2(y0.x - y2.x, y0.y - y2.y);
        const float2 b2 = make_float2(y1.x + y3.x, y1.y + y3.y), d = make_float2(y1.x - y3.x, y1.y - y3.y);
        const float2 b3 = make_float2(-d.y, d.x);
        ptr[0] = make_float2(b0.x + b2.x, b0.y + b2.y);
        ptr[Lq] = make_float2(b1.x + b3.x, b1.y + b3.y);
        ptr[2 * Lq] = make_float2(b0.x - b2.x, b0.y - b2.y);
        ptr[3 * Lq] = make_float2(b1.x - b3.x, b1.y - b3.y);
      }
    }
  }
  __syncthreads();
}
template <bool INV, int BATCH>
__device__ __forceinline__ void fft16k(float2* X, const float2* twh, const float2* twl, int tid) {
  if (!INV) {
    fft16k_stage<false, 0, BATCH>(X, twh, twl, tid); fft16k_stage<false, 1, BATCH>(X, twh, twl, tid); fft16k_stage<false, 2, BATCH>(X, twh, twl, tid);
    fft16k_stage<false, 3, BATCH>(X, twh, twl, tid); fft16k_stage<false, 4, BATCH>(X, twh, twl, tid); fft16k_stage<false, 5, BATCH>(X, twh, twl, tid);
    fft16k_stage<false, 6, BATCH>(X, twh, twl, tid);
  } else {
    fft16k_stage<true, 6, BATCH>(X, twh, twl, tid); fft16k_stage<true, 5, BATCH>(X, twh, twl, tid); fft16k_stage<true, 4, BATCH>(X, twh, twl, tid);
    fft16k_stage<true, 3, BATCH>(X, twh, twl, tid); fft16k_stage<true, 2, BATCH>(X, twh, twl, tid); fft16k_stage<true, 1, BATCH>(X, twh, twl, tid);
    fft16k_stage<true, 0, BATCH>(X, twh, twl, tid);
  }
}

__device__ void hyena_latent(PR p, int l, int c, unsigned char* smem) {
  float2* X = (float2*)smem;
  float2* twh = X + 16384;
  float2* twl = twh + 128;
  float* red = (float*)(twl + 128);
  const int tid = otid();
  float zf = 0.f;
  asm volatile("" : "+v"(zf));
  const float delta = fabsf(HY_MIN_DECAY + (float)c * ((HY_MAX_DECAY - HY_MIN_DECAY) / 255.0f));
  __syncthreads();
  if (tid < 128) {
    float sn, cs;
    sincospif((float)tid / 64.0f, &sn, &cs);
    twh[tid] = make_float2(cs, -sn);
  } else if (tid < 256) {
    float sn, cs;
    sincospif((float)(tid - 128) / 8192.0f, &sn, &cs);
    twl[tid - 128] = make_float2(cs, -sn);
  }
  f32x16v g0, g1, g2, g3;
  {
    const float* hf0p = p.HFT + ((size_t)l * 1024 + 0 * 256 + c) * 8192 + tid;
    const float* hb0p = p.HFT + ((size_t)l * 1024 + 1 * 256 + c) * 8192 + tid;
    const float* hf1p = p.HFT + ((size_t)l * 1024 + 2 * 256 + c) * 8192 + tid;
    const float* hb1p = p.HFT + ((size_t)l * 1024 + 3 * 256 + c) * 8192 + tid;
#pragma unroll
    for (int k = 0; k < 16; ++k) {
      g0[k] = __builtin_nontemporal_load(hf0p + NTH * k); g1[k] = __builtin_nontemporal_load(hb0p + NTH * k);
      g2[k] = __builtin_nontemporal_load(hf1p + NTH * k); g3[k] = __builtin_nontemporal_load(hb1p + NTH * k);
    }
  }
  f32x16v ua, ub, xa, xb;
#pragma unroll
  for (int i = 0; i < 16; ++i) {
    const int t = tid + NTH * i;
    ua[i] = hy_sconv(p, l, 0, t, SEQL, c); ub[i] = hy_sconv(p, l, SEQL, t, SEQL, c);
    xa[i] = hy_sconv(p, l, 0, t, SEQL, 256 + c); xb[i] = hy_sconv(p, l, SEQL, t, SEQL, 256 + c);
  }
  {
    __syncthreads();
    float l1a = 0.f, l1b = 0.f;
#pragma unroll
    for (int k = 0; k < 16; ++k) {
      const int i = tid + NTH * k;
      const float win = expf(-((float)i / 8191.0f) * delta);
      const float hf0 = g0[k] * win, hb0 = g1[k] * win, hf1 = g2[k] * win, hb1 = g3[k] * win;
      X[i] = make_float2(hf0, hf1);
      l1a += fabsf(hf0); l1b += fabsf(hf1);
      if (i >= 1) { X[16384 - i] = make_float2(hb0, hb1); l1a += fabsf(hb0); l1b += fabsf(hb1); }
    }
    if (tid == 0) X[8192] = make_float2(zf, zf);
    l1a = block_sum(l1a, red);
    l1b = block_sum(l1b, red);
    const float scl0 = 0.5f / (l1a * 16384.0f), scl1 = 0.5f / (l1b * 16384.0f);
    fft16k<false, 4>(X, twh, twl, tid);
    uint32_t* hs0 = p.HS + ((size_t)c * 2 + 0) * 16384;
    uint32_t* hs1 = p.HS + ((size_t)c * 2 + 1) * 16384;
#pragma unroll 4
    for (int idx = tid; idx < 16384; idx += NTH) {
      unsigned v = __brev((unsigned)idx) >> 18;
      v = ((v & 0x1555u) << 1) | ((v >> 1) & 0x1555u);
      const unsigned kq = (16384u - v) & 16383u;
      unsigned w_ = __brev(kq) >> 18;
      w_ = ((w_ & 0x1555u) << 1) | ((w_ >> 1) & 0x1555u);
      const float2 a_ = X[idx], b_ = X[w_];
      hs0[idx] = pk2bf((a_.x + b_.x) * scl0, (a_.y - b_.y) * scl0);
      hs1[idx] = pk2bf((a_.y + b_.y) * scl1, (b_.x - a_.x) * scl1);
    }
  }
  __syncthreads();
#pragma unroll
  for (int i = 0; i < 16; ++i) {
    const int t = tid + NTH * i;
    X[t] = make_float2(ua[i], ub[i]);
    X[8192 + t] = make_float2(zf, zf);
  }
  __syncthreads();
  u32x16v hq0a, hq0b;
  {
    const uint32_t* hs = p.HS + ((size_t)c * 2 + 0) * 16384 + tid;
#pragma unroll
    for (int i = 0; i < 16; ++i) { hq0a[i] = __builtin_nontemporal_load(hs + NTH * i); hq0b[i] = __builtin_nontemporal_load(hs + NTH * (16 + i)); }
  }
  fft16k<false, 2>(X, twh, twl, tid);
#pragma unroll
  for (int i = 0; i < 16; ++i) {
    const int ia = tid + NTH * i, ib = tid + NTH * (16 + i);
    X[ia] = cmul(X[ia], make_float2(bf2f((u16)(hq0a[i] & 0xFFFF)), bf2f((u16)(hq0a[i] >> 16))));
    X[ib] = cmul(X[ib], make_float2(bf2f((u16)(hq0b[i] & 0xFFFF)), bf2f((u16)(hq0b[i] >> 16))));
  }
  __syncthreads();
  fft16k<true, 2>(X, twh, twl, tid);
  {
    const float bias0 = p.hy_bias[(l * 2 + 0) * 256 + c];
#pragma unroll
    for (int i = 0; i < 16; ++i) {
      const int t = tid + NTH * i;
      const float2 y = X[t];
      const float z0 = xa[i] * (y.x + ua[i] * bias0);
      const float z1 = xb[i] * (y.y + ub[i] * bias0);
      ua[i] = z0; ub[i] = z1;
      X[t] = make_float2(z0, z1);
      X[8192 + t] = make_float2(zf, zf);
    }
#pragma unroll
    for (int i = 0; i < 16; ++i) {
      const int t = tid + NTH * i;
      xa[i] = hy_sconv(p, l, 0, t, SEQL, 512 + c); xb[i] = hy_sconv(p, l, SEQL, t, SEQL, 512 + c);
    }
  }
  __syncthreads();
  u32x16v hq1a, hq1b;
  {
    const uint32_t* hs = p.HS + ((size_t)c * 2 + 1) * 16384 + tid;
#pragma unroll
    for (int i = 0; i < 16; ++i) { hq1a[i] = __builtin_nontemporal_load(hs + NTH * i); hq1b[i] = __builtin_nontemporal_load(hs + NTH * (16 + i)); }
  }
  fft16k<false, 2>(X, twh, twl, tid);
#pragma unroll
  for (int i = 0; i < 16; ++i) {
    const int ia = tid + NTH * i, ib = tid + NTH * (16 + i);
    X[ia] = cmul(X[ia], make_float2(bf2f((u16)(hq1a[i] & 0xFFFF)), bf2f((u16)(hq1a[i] >> 16))));
    X[ib] = cmul(X[ib], make_float2(bf2f((u16)(hq1b[i] & 0xFFFF)), bf2f((u16)(hq1b[i] >> 16))));
  }
  __syncthreads();
  fft16k<true, 2>(X, twh, twl, tid);
  {
    const float bias1 = p.hy_bias[(l * 2 + 1) * 256 + c];
#pragma unroll
    for (int i = 0; i < 16; ++i) {
      const int t = tid + NTH * i;
      const float2 y = X[t];
      p.HYRAW[(size_t)c * NROW + lat_row(0, t)] = xa[i] * (y.x + ua[i] * bias1);
      p.HYRAW[(size_t)c * NROW + lat_row(1, t)] = xb[i] * (y.y + ub[i] * bias1);
    }
  }
  __syncthreads();
}

__device__ void hyena_ctx(PR p, int l, int c, unsigned char* smem) {
  float* G = (float*)smem;
  float* U = G + 512;
  float* red = U + 512;
  const int tid = otid();
  const float delta = fabsf(HY_MIN_DECAY + (float)c * ((HY_MAX_DECAY - HY_MIN_DECAY) / 255.0f));
  const int b = tid >> 8, t = tid & 255;
  float zr = 0.f;
  for (int order = 0; order < 2; ++order) {
    __syncthreads();
    float l1 = 0.f;
    if (tid < 256) {
      const int i = tid;
      const float win = expf(-((float)i / 255.0f) * delta);
      const float hf = p.HFTC[(size_t)((order * 2 + 0) * 256 + c) * 256 + i] * win;
      const float hb = p.HFTC[(size_t)((order * 2 + 1) * 256 + c) * 256 + i] * win;
      G[256 + i] = hf;
      l1 += fabsf(hf);
      if (i >= 1) { G[256 - i] = hb; l1 += fabsf(hb); }
      if (i == 0) G[0] = 0.f;
    }
    if (order == 0) U[tid] = hy_sconv(p, l, NLAT + b * CTXL, t, CTXL, c);
    else U[tid] = zr;
    l1 = block_sum(l1, red);
    const float inv_l1 = 1.0f / l1;
    float acc = 0.f;
#pragma unroll 4
    for (int s2 = 0; s2 < 256; ++s2) acc += G[256 + t - s2] * U[b * 256 + s2];
    const float y = acc * inv_l1 + U[tid] * p.hy_bias[(l * 2 + order) * 256 + c];
    if (order == 0) zr = hy_sconv(p, l, NLAT + b * CTXL, t, CTXL, 256 + c) * y;
    else p.HYRAW[(size_t)c * NROW + ctx_row(b, t)] = hy_sconv(p, l, NLAT + b * CTXL, t, CTXL, 512 + c) * y;
  }
  __syncthreads();
}

struct MixLds {
  u16 Qt[64 * 72];
  u16 Qi[64 * 72];
  u16 Ki[160 * 72];
  u16 KT[64 * 72];
  u16 VT[64 * 72];
  u16 AT[64 * 72];
  u16 ST[64 * 72];
  float osum[64 * 64];
  float wt[8 * 64];
  float dnp[8 * 64];
  float nv[64];
  float den[64];
};
template <int MIX> struct MixCfg;
template <> struct MixCfg<0> { static constexpr int DK = 64; static constexpr bool HASN = false; };
template <> struct MixCfg<1> { static constexpr int DK = 32; static constexpr bool HASN = false; };
template <> struct MixCfg<2> { static constexpr int DK = 64; static constexpr bool HASN = true; };

__device__ __forceinline__ u16* mix_sb(PR p, int mix) { return mix == 0 ? p.SBHG : (mix == 1 ? p.SBGL : p.SBML); }
__device__ __forceinline__ float* mix_dc(PR p, int mix) { return mix == 0 ? p.DCHG : (mix == 1 ? p.DCGL : p.DCML); }

struct MixRaw { f32x8v v, x0, x1, x2; f32x16v rq, rk; };

template <int MIX, bool NEEDQ>
__device__ __forceinline__ void mix_fetch(PR p, int l, int b, int h, int dir, int cc, int tid, MixRaw& r) {
  constexpr int DK = MixCfg<MIX>::DK;
  const int lane = tid & 63, w = tid >> 6;
  const int seg = cc < 4 ? 0 : 1;
  const int kc = seg ? cc - 4 : cc;
  const int L = seg ? SEQL : CTXL;
  const int rowbase = seg ? b * SEQL : NLAT + b * CTXL;
  if (MIX == 2) {
    const int tfirst = dir ? (L - 1 - (kc * 64 + w * 8)) : (kc * 64 + w * 8);
#pragma unroll
    for (int j = 0; j < 10; ++j) {
      const int tr = dir ? (tfirst + 1 - j) : (tfirst - 1 + j);
      const bool ok = (tr >= 0) && (tr < L);
      const u16* Prr = p.P + (size_t)(rowbase + (ok ? tr : tfirst)) * DIN + 2848 + h * 64 + lane;
      const float a_ = NEEDQ ? bf2f(Prr[0]) : 0.f, b_ = bf2f(Prr[256]);
      r.rq[j] = ok ? a_ : 0.f; r.rk[j] = ok ? b_ : 0.f;
    }
  }
#pragma unroll
  for (int i = 0; i < 8; ++i) {
    const int tau = kc * 64 + w * 8 + i;
    const int t = dir ? (L - 1 - tau) : tau;
    const u16* Pr = p.P + (size_t)(rowbase + t) * DIN;
    if (MIX == 0) {
      r.v[i] = bf2f(Pr[1024 + h * 64 + lane]);
      r.x0[i] = bf2f(Pr[(dir ? 1536 : 1280) + h * 64 + lane]);
      if (NEEDQ) r.x1[i] = bf2f(Pr[768 + h * 64 + lane]);
    } else if (MIX == 1) {
      r.v[i] = bf2f(Pr[2304 + h * 64 + lane]);
      r.x0[i] = bf2f(Pr[2176 + h * 32 + (lane & 31)]);
      if (NEEDQ) r.x1[i] = bf2f(Pr[2048 + h * 32 + (lane & 31)]);
      r.x2[i] = bf2f(Pr[2560 + dir * 16 + (lane & 15)]);
    } else {
      r.v[i] = bf2f(Pr[3360 + h * 64 + lane]);
      r.x0[i] = bf2f(Pr[3616 + (dir ? 8 : 0) + h]);
      r.x1[i] = bf2f(Pr[3616 + (dir ? 12 : 4) + h]);
    }
  }
}

struct MixPar { f32x16v au; float gab, lb, ck0, ck1, ck2, ckb, cq0, cq1, cq2, cqb, igb, fgb; };
template <int MIX, bool NEEDQ>
__device__ __forceinline__ void mix_params(PR p, int l, int h, int dir, int tid, MixPar& mp) {
  const int lane = tid & 63;
  if (MIX == 1) {
    const int d = lane & 31;
#pragma unroll
    for (int q_ = 0; q_ < 16; ++q_) mp.au[q_] = p.gla_a_up[(size_t)(l * 2 + dir) * 16 * 128 + q_ * 128 + h * 32 + d];
    mp.gab = p.gla_a_b[(l * 2 + dir) * 128 + h * 32 + d];
  } else if (MIX == 0) {
    mp.lb = p.LBv[l * 256 + h * 64 + lane];
  } else {
    const int chq = h * 64 + lane, chk = 256 + h * 64 + lane;
    const float* cw = p.ml_conv_w + (size_t)l * 3 * 512;
    mp.ck0 = cw[chk]; mp.ck1 = cw[512 + chk]; mp.ck2 = cw[1024 + chk]; mp.ckb = p.ml_conv_b[l * 512 + chk];
    if (NEEDQ) { mp.cq0 = cw[chq]; mp.cq1 = cw[512 + chq]; mp.cq2 = cw[1024 + chq]; mp.cqb = p.ml_conv_b[l * 512 + chq]; }
    mp.igb = p.ml_gate_b[l * 16 + (dir ? 8 : 0) + h];
    mp.fgb = p.ml_gate_b[l * 16 + (dir ? 12 : 4) + h];
  }
}

template <int MIX, bool NEEDQ, int DIR>
__device__ __forceinline__ void mix_xform(PR p, int l, int h, int tid, const MixRaw& r, const MixPar& mp, MixLds* m, float (&qv)[8], float (&kv)[8],
                                          float (&bv)[8], float (&vv)[8], float& B1, float& B2, float& B3, float& bl) {
  constexpr int DK = MixCfg<MIX>::DK;
  constexpr int dir = DIR;
  const int lane = tid & 63, w = tid >> 6;
#pragma unroll
  for (int i = 0; i < 8; ++i) {
    vv[i] = r.v[i];
    float q = 0.f, k = 0.f, g = 0.f;
    if (MIX == 1) {
      float a = mp.gab;
#pragma unroll
      for (int q_ = 0; q_ < 16; ++q_) a += shu(r.x2[i], q_) * mp.au[q_];
      if (lane < DK) {
        if (NEEDQ) q = r.x1[i] * 0.17677669529663687f;
        k = r.x0[i];
        g = flogsigmoid(a) * (1.f / 16.f);
      }
    } else if (MIX == 0) {
      const float z = r.x0[i];
      const float lb = mp.lb;
      const float ls = flogsigmoid(z);
      k = (1.f - lb) * frcp(1.f + fexp(z));
      g = (lb > 0.f) ? __logf(lb + (1.f - lb) * fexp(ls)) : ls;
      if (NEEDQ) q = fsilu(r.x1[i]);
    } else {
      const float kp = dir ? r.rk[i + 2] : r.rk[i], kn = dir ? r.rk[i] : r.rk[i + 2];
      const float ck = mp.ckb + kp * mp.ck0 + r.rk[i + 1] * mp.ck1 + kn * mp.ck2;
      if (NEEDQ) {
        const float qp = dir ? r.rq[i + 2] : r.rq[i], qn = dir ? r.rq[i] : r.rq[i + 2];
        const float cq = mp.cqb + qp * mp.cq0 + r.rq[i + 1] * mp.cq1 + qn * mp.cq2;
        q = fsilu(cq);
      }
      const float ig = r.x0[i] + mp.igb;
      const float fg = r.x1[i] + mp.fgb;
      k = fsilu(ck) * 0.125f * fexp(ig);
      g = flogsigmoid(fg);
    }
    qv[i] = q; kv[i] = k; bv[i] = g;
  }
  float run = 0.f;
#pragma unroll
  for (int i = 0; i < 8; ++i) { run += bv[i]; bv[i] = run; }
  __syncthreads();
  m->wt[w * 64 + lane] = run;
  __syncthreads();
  float off = 0.f;
  B1 = 0.f; B2 = 0.f; B3 = 0.f; bl = 0.f;
#pragma unroll
  for (int ww = 0; ww < 8; ++ww) {
    const float x = m->wt[ww * 64 + lane];
    if (ww < w) off += x;
    if (ww < 2) B1 += x;
    if (ww < 4) B2 += x;
    if (ww < 6) B3 += x;
    bl += x;
  }
#pragma unroll
  for (int i = 0; i < 8; ++i) bv[i] += off;
}

__device__ __forceinline__ uint4 pack8(const float (&x)[8]) {
  uint4 r;
  r.x = pk2bf(x[0], x[1]);
  r.y = pk2bf(x[2], x[3]);
  r.z = pk2bf(x[4], x[5]);
  r.w = pk2bf(x[6], x[7]);
  return r;
}
__device__ __forceinline__ bf16x8 lds_frag(const u16* base, int row0, int k0, int lane) {
  return *(const bf16x8*)(base + (row0 + (lane & 15)) * 72 + k0 + (lane >> 4) * 8);
}

template <int MIX>
__device__ __forceinline__ void mix_summary(PR p, int l, int chain, int cc, const MixRaw& raw, const MixPar& mp, MixLds* m) {
  constexpr int DK = MixCfg<MIX>::DK;
  const int tid = otid();
  const int lane = tid & 63, w = tid >> 6;
  const int h = (chain >> 1) & 3;
  float qv[8], kv[8], bv[8], vv[8], B1, B2, B3, bl;
  if (chain & 1) mix_xform<MIX, false, 1>(p, l, h, tid, raw, mp, m, qv, kv, bv, vv, B1, B2, B3, bl);
  else mix_xform<MIX, false, 0>(p, l, h, tid, raw, mp, m, qv, kv, bv, vv, B1, B2, B3, bl);
  float ke[8];
  float dn = 0.f;
#pragma unroll
  for (int i = 0; i < 8; ++i) { ke[i] = kv[i] * fexp(bl - bv[i]); dn += ke[i]; }
  if (lane < DK) *(uint4*)(&m->KT[lane * 72 + w * 8]) = pack8(ke);
  *(uint4*)(&m->VT[lane * 72 + w * 8]) = pack8(vv);
  if (MIX == 2) m->dnp[w * 64 + lane] = dn;
  __syncthreads();
  u16* sb = mix_sb(p, MIX) + ((size_t)chain * NCH + cc) * (DK * 64);
  for (int tile = w; tile < (DK / 16) * 4; tile += 8) {
    const int db = tile >> 2, vb = tile & 3;
    f32x4 acc = {0.f, 0.f, 0.f, 0.f};
#pragma unroll
    for (int ks = 0; ks < 2; ++ks)
      acc = __builtin_amdgcn_mfma_f32_16x16x32_bf16(lds_frag(m->KT, db * 16, ks * 32, lane), lds_frag(m->VT, vb * 16, ks * 32, lane), acc, 0, 0, 0);
#pragma unroll
    for (int r = 0; r < 4; ++r) sb[(db * 16 + (lane >> 4) * 4 + r) * 64 + vb * 16 + (lane & 15)] = f2bf(acc[r]);
  }
  if (w == 0 && lane < DK) mix_dc(p, MIX)[((size_t)chain * NCH + cc) * DK + lane] = fexp(bl);
  if (MIX == 2 && w == 1) {
    float s2 = 0.f;
#pragma unroll
    for (int ww = 0; ww < 8; ++ww) s2 += m->dnp[ww * 64 + lane];
    p.NBML[((size_t)chain * NCH + cc) * 64 + lane] = s2;
  }
}

template <int MIX, int DIR>
__device__ __forceinline__ void mix_output_dir(PR p, int l, int b, int h, int tid, const MixRaw& raw, const float (&sv)[8], float nvp, MixLds* m) {
  constexpr int DK = MixCfg<MIX>::DK;
  constexpr bool HASN = MixCfg<MIX>::HASN;
  constexpr int dir = DIR;
  const int lane = tid & 63, w = tid >> 6;
  float qv[8], kv[8], bv[8], vv[8], B1, B2, B3, bl;
  MixPar mp;
  mix_params<MIX, true>(p, l, h, DIR, tid, mp);
  mix_xform<MIX, true, DIR>(p, l, h, tid, raw, mp, m, qv, kv, bv, vv, B1, B2, B3, bl);
  const int J = w >> 1;
  const float BJ = (J == 0) ? 0.f : (J == 1 ? B1 : (J == 2 ? B2 : B3));
  if (lane < DK) {
#pragma unroll
    for (int i = 0; i < 8; ++i) {
      const int tau = w * 8 + i;
      m->Qt[tau * 72 + lane] = f2bf(qv[i] * fexp(bv[i]));
      m->Qi[tau * 72 + lane] = f2bf(qv[i] * fexp(bv[i] - BJ));
      if (J <= 0) m->Ki[(0 + tau) * 72 + lane] = f2bf(kv[i] * fexp(fminf(0.f - bv[i], 80.f)));
      if (J <= 1) m->Ki[(16 + tau) * 72 + lane] = f2bf(kv[i] * fexp(fminf(B1 - bv[i], 80.f)));
      if (J <= 2) m->Ki[(48 + tau) * 72 + lane] = f2bf(kv[i] * fexp(fminf(B2 - bv[i], 80.f)));
      m->Ki[(96 + tau) * 72 + lane] = f2bf(kv[i] * fexp(fminf(B3 - bv[i], 80.f)));
    }
  }
  *(uint4*)(&m->VT[lane * 72 + w * 8]) = pack8(vv);
  {
    constexpr int DPW = DK / 8;
    if (DPW == 8) *(uint4*)(&m->ST[lane * 72 + w * 8]) = pack8(sv);
    else *(uint2*)(&m->ST[lane * 72 + w * 4]) = make_uint2(pk2bf(sv[0], sv[1]), pk2bf(sv[2], sv[3]));
    if (HASN && w == 0) m->nv[lane] = nvp;
  }
  __syncthreads();
#pragma unroll
  for (int q = 0; q < 2; ++q) {
    const int blk = w * 2 + q;
    const int I = blk >> 2, Jb = blk & 3;
    f32x4 acc = {0.f, 0.f, 0.f, 0.f};
    if (Jb <= I) {
      const int kioff = (I == 0) ? 0 : (I == 1 ? 16 : (I == 2 ? 48 : 96));
#pragma unroll
      for (int ks = 0; ks < DK / 32; ++ks)
        acc = __builtin_amdgcn_mfma_f32_16x16x32_bf16(lds_frag(m->Qi, I * 16, ks * 32, lane), lds_frag(m->Ki, kioff + Jb * 16, ks * 32, lane), acc, 0, 0, 0);
    }
#pragma unroll
    for (int r = 0; r < 4; ++r) {
      const int tl_ = (lane >> 4) * 4 + r, sl_ = lane & 15;
      float a = acc[r];
      if (Jb == I && sl_ > tl_) a = 0.f;
      m->AT[(I * 16 + tl_) * 72 + Jb * 16 + sl_] = f2bf(a);
    }
  }
  __syncthreads();
  if (HASN) {
#pragma unroll
    for (int i = 0; i < 8; ++i) {
      const int tau = w * 8 + i;
      float x = bf2f(m->AT[tau * 72 + lane]) + bf2f(m->Qt[tau * 72 + lane]) * m->nv[lane];
      x = wave_sum(x);
      if (lane == 0) m->den[tau] = fmaxf(fabsf(x), 1.0f);
    }
    __syncthreads();
  }
#pragma unroll
  for (int q = 0; q < 2; ++q) {
    const int tile = w * 2 + q;
    const int I = tile >> 2, vb = tile & 3;
    f32x4 acc = {0.f, 0.f, 0.f, 0.f};
#pragma unroll
    for (int ks = 0; ks < DK / 32; ++ks)
      acc = __builtin_amdgcn_mfma_f32_16x16x32_bf16(lds_frag(m->Qt, I * 16, ks * 32, lane), lds_frag(m->ST, vb * 16, ks * 32, lane), acc, 0, 0, 0);
#pragma unroll
    for (int ks = 0; ks < 2; ++ks)
      acc = __builtin_amdgcn_mfma_f32_16x16x32_bf16(lds_frag(m->AT, I * 16, ks * 32, lane), lds_frag(m->VT, vb * 16, ks * 32, lane), acc, 0, 0, 0);
#pragma unroll
    for (int r = 0; r < 4; ++r) {
      const int tau = I * 16 + (lane >> 4) * 4 + r;
      float o = acc[r];
      if (HASN) o *= frcp(m->den[tau]);
      const int slot = dir ? 63 - tau : tau;
      m->osum[slot * 64 + vb * 16 + (lane & 15)] += o;
    }
  }
  __syncthreads();
}

template <int MIX>
__device__ __forceinline__ void mix_output(PR p, int l, int b, int h, int seg, int j, MixLds* m) {
  constexpr int DK = MixCfg<MIX>::DK;
  constexpr int DPW = DK / 8;
  const int tid = otid();
  const int lane = tid & 63, w = tid >> 6;
  const int nseg = seg ? 128 : 4;
  const int cbase = seg ? 4 : 0;
  const int L = seg ? SEQL : CTXL;
  const int rowbase = seg ? b * SEQL : NLAT + b * CTXL;
  const int cc0 = cbase + j, cc1 = cbase + (nseg - 1 - j);
  const int chain0 = (b * 4 + h) * 2, chain1 = chain0 + 1;
  MixRaw r0, r1;
  mix_fetch<MIX, true>(p, l, b, h, 0, cc0, tid, r0);
  mix_fetch<MIX, true>(p, l, b, h, 1, cc1, tid, r1);
  float sv0[8], sv1[8], gate[8];
  {
    const u16* sb0 = mix_sb(p, MIX) + ((size_t)chain0 * NCH + cc0) * (DK * 64);
    const u16* sb1 = mix_sb(p, MIX) + ((size_t)chain1 * NCH + cc1) * (DK * 64);
#pragma unroll
    for (int i = 0; i < 8; ++i) {
      sv0[i] = (i < DPW) ? bf2f(__builtin_nontemporal_load(sb0 + (w * DPW + i) * 64 + lane)) : 0.f;
      sv1[i] = (i < DPW) ? bf2f(__builtin_nontemporal_load(sb1 + (w * DPW + i) * 64 + lane)) : 0.f;
    }
  }
  const float nv0 = (MIX == 2) ? p.NBML[((size_t)chain0 * NCH + cc0) * 64 + lane] : 0.f;
  const float nv1 = (MIX == 2) ? p.NBML[((size_t)chain1 * NCH + cc1) * 64 + lane] : 0.f;
#pragma unroll
  for (int i = 0; i < 8; ++i) {
    const int t = j * 64 + w + 8 * i;
    const u16* Pr = p.P + (size_t)(rowbase + t) * DIN;
    gate[i] = bf2f(__builtin_nontemporal_load(Pr + ((MIX == 0) ? 1792 : (MIX == 1 ? 2592 : 3632)) + h * 64 + lane));
  }
  __syncthreads();
  for (int idx = tid; idx < 4096; idx += NTH) m->osum[idx] = 0.f;
  mix_output_dir<MIX, 0>(p, l, b, h, tid, r0, sv0, nv0, m);
  mix_output_dir<MIX, 1>(p, l, b, h, tid, r1, sv1, nv1, m);
#pragma unroll
  for (int i = 0; i < 8; ++i) {
    const int tk = w + 8 * i;
    const int t = j * 64 + tk;
    const float o = m->osum[tk * 64 + lane];
    const float ms = wave_sum(o * o) * (1.f / 64.f);
    const float on = o * rsqrtf(ms + EPSV);
    float y;
    int col;
    if (MIX == 0) { y = on * p.hg_norm[l * 256 + h * 64 + lane] * fsilu(gate[i]); col = 256 + h * 64 + lane; }
    else if (MIX == 1) { y = on * p.gla_norm[l * 256 + h * 64 + lane] * fsilu(gate[i]); col = 512 + h * 64 + lane; }
    else { y = fsigmoid(gate[i]) * on * p.ml_norm[l * 256 + h * 64 + lane]; col = 768 + h * 64 + lane; }
    p.YMIX[(size_t)(rowbase + t) * DM + col] = f2bf(y);
  }
}

template <int MIX>
__device__ __forceinline__ void mixA_loop(PR p, int l, MixLds* m) {
  const int NQ = 16 * NCH, G = gridDim.x;
  const int tid = otid();
  int q0 = ((int)blockIdx.x + G - (MIX * 85) % G) % G;
  MixRaw ra, rb;
  MixPar pa, pb;
#define MIXA_FETCH(Q, R) { const int qq_ = min((Q), NQ - 1); const int chain_ = qq_ / NCH, cc_ = qq_ % NCH; \
    mix_fetch<MIX, false>(p, l, chain_ >> 3, (chain_ >> 1) & 3, chain_ & 1, cc_, tid, R); }
#define MIXA_PAR(Q, PP) { const int chain_ = min((Q), NQ - 1) / NCH; mix_params<MIX, false>(p, l, (chain_ >> 1) & 3, chain_ & 1, tid, PP); }
#define MIXA_ITEM(Q, R, PP) { const int chain_ = (Q) / NCH, cc_ = (Q) % NCH; mix_summary<MIX>(p, l, chain_, cc_, R, PP, m); }
  MIXA_FETCH(q0, ra)
  for (; q0 < NQ; q0 += 2 * G) {
    const int q1 = q0 + G, q2 = q0 + 2 * G;
    MIXA_PAR(q0, pa)
    MIXA_FETCH(q1, rb)
    MIXA_ITEM(q0, ra, pa)
    MIXA_PAR(q1, pb)
    MIXA_FETCH(q2, ra)
    if (q1 < NQ) MIXA_ITEM(q1, rb, pb)
  }
#undef MIXA_PAR
#undef MIXA_FETCH
#undef MIXA_ITEM
}
__device__ __forceinline__ void phase_mixA(PR p, int l, unsigned char* smem) {
  MixLds* m = (MixLds*)smem;
  const int n_hy = 256 + (l == 0 ? 256 : 0);
  for (int it = blockIdx.x; it < n_hy; it += gridDim.x) {
    if (it < 256) hyena_latent(p, l, it, smem);
    else hyena_ctx(p, l, it - 256, smem);
  }
  mixA_loop<0>(p, l, m);
  mixA_loop<1>(p, l, m);
  mixA_loop<2>(p, l, m);
}

__device__ __forceinline__ float scan_ld(const u16* q) { return bf2f(__builtin_nontemporal_load(q)); }
__device__ __forceinline__ float scan_ld(const float* q) { return __builtin_nontemporal_load(q); }
__device__ __forceinline__ void scan_st(u16* q, float v) { *q = f2bf(v); }
__device__ __forceinline__ void scan_st(float* q, float v) { *q = v; }
template <class T>
__device__ __forceinline__ void scan_chain(T* ptr, const float* dp, int sz, int dk) {
  float s = 0.f;
  float dv0 = scan_ld(ptr + 0 * (size_t)sz), dv1 = scan_ld(ptr + 1 * (size_t)sz), dv2 = scan_ld(ptr + 2 * (size_t)sz), dv3 = scan_ld(ptr + 3 * (size_t)sz);
  float de0 = dp[0 * dk], de1 = dp[1 * dk], de2 = dp[2 * dk], de3 = dp[3 * dk];
  for (int cc = 0; cc < NCH; cc += 4) {
    float nv0 = 0.f, nv1 = 0.f, nv2 = 0.f, nv3 = 0.f, ne0 = 0.f, ne1 = 0.f, ne2 = 0.f, ne3 = 0.f;
    if (cc + 4 < NCH) {
      nv0 = scan_ld(ptr + (size_t)(cc + 4) * sz); nv1 = scan_ld(ptr + (size_t)(cc + 5) * sz);
      nv2 = scan_ld(ptr + (size_t)(cc + 6) * sz); nv3 = scan_ld(ptr + (size_t)(cc + 7) * sz);
      ne0 = dp[(cc + 4) * dk]; ne1 = dp[(cc + 5) * dk]; ne2 = dp[(cc + 6) * dk]; ne3 = dp[(cc + 7) * dk];
    }
    scan_st(ptr + (size_t)(cc + 0) * sz, s); s = de0 * s + dv0;
    scan_st(ptr + (size_t)(cc + 1) * sz, s); s = de1 * s + dv1;
    scan_st(ptr + (size_t)(cc + 2) * sz, s); s = de2 * s + dv2;
    scan_st(ptr + (size_t)(cc + 3) * sz, s); s = de3 * s + dv3;
    dv0 = nv0; dv1 = nv1; dv2 = nv2; dv3 = nv3; de0 = ne0; de1 = ne1; de2 = ne2; de3 = ne3;
  }
}
__device__ __forceinline__ void scan_chain2(u16* ptr, const float* dp, int sz, int dk) {
  float s0 = 0.f, s1 = 0.f;
#define SC_LD(C) __builtin_nontemporal_load((const uint32_t*)(ptr + (size_t)(C) * sz))
#define SC_ST(C) *(uint32_t*)(ptr + (size_t)(C) * sz) = pk2bf(s0, s1)
#define SC_UP(D, V) s0 = (D) * s0 + bf2f((u16)((V) & 0xFFFF)); s1 = (D) * s1 + bf2f((u16)((V) >> 16))
  uint32_t dv0 = SC_LD(0), dv1 = SC_LD(1), dv2 = SC_LD(2), dv3 = SC_LD(3);
  float de0 = dp[0 * dk], de1 = dp[1 * dk], de2 = dp[2 * dk], de3 = dp[3 * dk];
  for (int cc = 0; cc < NCH; cc += 4) {
    uint32_t nv0 = 0, nv1 = 0, nv2 = 0, nv3 = 0;
    float ne0 = 0.f, ne1 = 0.f, ne2 = 0.f, ne3 = 0.f;
    if (cc + 4 < NCH) {
      nv0 = SC_LD(cc + 4); nv1 = SC_LD(cc + 5); nv2 = SC_LD(cc + 6); nv3 = SC_LD(cc + 7);
      ne0 = dp[(cc + 4) * dk]; ne1 = dp[(cc + 5) * dk]; ne2 = dp[(cc + 6) * dk]; ne3 = dp[(cc + 7) * dk];
    }
    SC_ST(cc + 0); SC_UP(de0, dv0);
    SC_ST(cc + 1); SC_UP(de1, dv1);
    SC_ST(cc + 2); SC_UP(de2, dv2);
    SC_ST(cc + 3); SC_UP(de3, dv3);
    dv0 = nv0; dv1 = nv1; dv2 = nv2; dv3 = nv3; de0 = ne0; de1 = ne1; de2 = ne2; de3 = ne3;
  }
#undef SC_LD
#undef SC_ST
#undef SC_UP
}
__device__ __forceinline__ void phase_scan(PR p, int l) {
  const int gt = blockIdx.x * NTH + otid(), ntot = gridDim.x * NTH;
  const int n0 = 16 * 2048, n1 = 16 * 1024, n2 = 16 * 2048, n3 = 16 * 64;
  for (int e = gt; e < n0 + n1 + n2 + n3; e += ntot) {
    if (e < n0 + n1 + n2) {
      u16* sb; const float* dc; int sz, dk, chain, idx;
      if (e < n0) { sb = p.SBHG; dc = p.DCHG; sz = 4096; dk = 64; chain = e / 2048; idx = (e % 2048) * 2; }
      else if (e < n0 + n1) { const int q = e - n0; sb = p.SBGL; dc = p.DCGL; sz = 2048; dk = 32; chain = q / 1024; idx = (q % 1024) * 2; }
      else { const int q = e - n0 - n1; sb = p.SBML; dc = p.DCML; sz = 4096; dk = 64; chain = q / 2048; idx = (q % 2048) * 2; }
      scan_chain2(sb + ((size_t)chain * NCH) * sz + idx, dc + ((size_t)chain * NCH) * dk + (idx >> 6), sz, dk);
    } else {
      const int q = e - n0 - n1 - n2;
      const int chain = q / 64, d = q % 64;
      scan_chain(p.NBML + ((size_t)chain * NCH) * 64 + d, p.DCML + ((size_t)chain * NCH) * 64 + d, 64, 64);
    }
  }
}

__device__ __forceinline__ void phase_mixC(PR p, int l, unsigned char* smem) {
  MixLds* m = (MixLds*)smem;
  const int nchk = (l == 0) ? 132 : 128;
  const int n_mix = 2 * nchk * 12;
  for (int it = blockIdx.x; it < n_mix; it += gridDim.x) {
    const int rg = it / 12, sub = it % 12;
    const int mix = sub >> 2, h = sub & 3;
    const int b = rg / nchk, c = rg % nchk;
    const int seg = c < 128 ? 1 : 0, j = c < 128 ? c : c - 128;
    if (mix == 0) mix_output<0>(p, l, b, h, seg, j, m);
    else if (mix == 1) mix_output<1>(p, l, b, h, seg, j, m);
    else mix_output<2>(p, l, b, h, seg, j, m);
  }
  {
    float* tl = (float*)smem;
    const int tid = otid();
    const int lane = tid & 63, w = tid >> 6;
    const int nrows = (l == 0) ? NROW : NLAT;
    for (int it = blockIdx.x; it < nrows / 64; it += gridDim.x) {
      const int r0 = it * 64;
      __syncthreads();
      {
        float hv[32];
#pragma unroll
        for (int i = 0; i < 32; ++i) hv[i] = __builtin_nontemporal_load(p.HYRAW + (size_t)((tid >> 6) + 8 * i) * NROW + r0 + (tid & 63));
#pragma unroll
        for (int i = 0; i < 32; ++i) tl[((tid >> 6) + 8 * i) * 65 + (tid & 63)] = hv[i];
      }
      __syncthreads();
      for (int rr = w; rr < 64; rr += 8) {
        float v[4];
        float ss = 0.f;
#pragma unroll
        for (int q = 0; q < 4; ++q) { v[q] = tl[(lane * 4 + q) * 65 + rr]; ss += v[q] * v[q]; }
        const float rs = rsqrtf(wave_sum(ss) * (1.f / 256.f) + EPSV);
        const float4 g = *(const float4*)(p.hy_norm + l * 256 + lane * 4);
        uint2 o;
        o.x = (uint32_t)f2bf(v[0] * rs * g.x) | ((uint32_t)f2bf(v[1] * rs * g.y) << 16);
        o.y = (uint32_t)f2bf(v[2] * rs * g.z) | ((uint32_t)f2bf(v[3] * rs * g.w) << 16);
        *(uint2*)(p.YMIX + (size_t)(r0 + rr) * DM + lane * 4) = o;
      }
    }
  }
}

__device__ __forceinline__ void phase_outproj(PR p, int l, unsigned char* smem) {
  const int nM = ((l == 0) ? NROW : NLAT) / 256;
  u16* YO_ = p.YOB;
  TileIter ti;
  for (int it = ti.next(nM * 4); it >= 0; it = ti.next(nM * 4)) {
    int pm, pn;
    g8_tile(it, nM, 4, pm, pn);
    gemm256<false, false, 1>(p.YMIX, p.YMIX, 1 << 30, DM, p.WoutT + (size_t)l * 1024 * 1024, DM, pm * 256, pn * 256, smem,
                   [&](int row, int col, const float4& v, const float4&) {
                     *(uint2*)(YO_ + (size_t)row * DM + col) = make_uint2(pk2bf(v.x, v.y), pk2bf(v.z, v.w));
                   });
  }
}

__device__ __forceinline__ void phase_post1(PR p, int l) {
  const int tid_ = otid();
  const int lane = tid_ & 63;
  const int gw = blockIdx.x * 8 + (tid_ >> 6), nw = gridDim.x * 8;
  const float* ng1 = p.norm_g + (l * 4 + 1) * DM;
  const float* ng2 = p.norm_g + (l * 4 + 2) * DM;
  const int nrows = (l == 0) ? NROW : NLAT;
  for (int r = gw; r < nrows; r += nw) {
    const float* mod = p.MOD + (l * 3 + mod_index(r)) * 6144;
    float4 yv[4], xv[4];
    float ss = 0.f;
#pragma unroll
    for (int q = 0; q < 4; ++q) {
      const u32x2v yb = __builtin_nontemporal_load((const u32x2v*)(p.YOB + (size_t)r * DM + q * 256 + lane * 4));
      yv[q] = make_float4(bf2f((u16)(yb.x & 0xFFFF)), bf2f((u16)(yb.x >> 16)), bf2f((u16)(yb.y & 0xFFFF)), bf2f((u16)(yb.y >> 16)));
      ss += yv[q].x * yv[q].x + yv[q].y * yv[q].y + yv[q].z * yv[q].z + yv[q].w * yv[q].w;
    }
    ss = wave_sum(ss);
    const float rs = rsqrtf(ss * (1.f / DM) + EPSV);
    float s2 = 0.f;
#pragma unroll
    for (int q = 0; q < 4; ++q) {
      const int e = q * 256 + lane * 4;
      const float4 gv = *(const float4*)(ng1 + e);
      const float4 g1 = *(const float4*)(mod + 2048 + e);
      float4 xx = ldx4(p.X + (size_t)r * DM + e);
      xx.x += g1.x * (yv[q].x * rs * gv.x); xx.y += g1.y * (yv[q].y * rs * gv.y);
      xx.z += g1.z * (yv[q].z * rs * gv.z); xx.w += g1.w * (yv[q].w * rs * gv.w);
      xv[q] = xx;
      stx4(p.X + (size_t)r * DM + e, xx);
      s2 += xx.x * xx.x + xx.y * xx.y + xx.z * xx.z + xx.w * xx.w;
    }
    s2 = wave_sum(s2);
    const float rs2 = rsqrtf(s2 * (1.f / DM) + EPSV);
#pragma unroll
    for (int q = 0; q < 4; ++q) {
      const int e = q * 256 + lane * 4;
      const float4 gv = *(const float4*)(ng2 + e);
      const float4 sh = *(const float4*)(mod + 3072 + e);
      const float4 sc = *(const float4*)(mod + 4096 + e);
      float4 hv;
      hv.x = xv[q].x * rs2 * gv.x * (1.f + sc.x) + sh.x; hv.y = xv[q].y * rs2 * gv.y * (1.f + sc.y) + sh.y;
      hv.z = xv[q].z * rs2 * gv.z * (1.f + sc.z) + sh.z; hv.w = xv[q].w * rs2 * gv.w * (1.f + sc.w) + sh.w;
      uint2 o;
      o.x = pk2bf(hv.x, hv.y);
      o.y = pk2bf(hv.z, hv.w);
      *(uint2*)(p.HN + (size_t)r * DM + e) = o;
      uint2 o2;
      o2.x = pk2bf(hv.x - bf2f((u16)(o.x & 0xFFFF)), hv.y - bf2f((u16)(o.x >> 16)));
      o2.y = pk2bf(hv.z - bf2f((u16)(o.y & 0xFFFF)), hv.w - bf2f((u16)(o.y >> 16)));
      *(uint2*)(p.HLO + (size_t)r * DM + e) = o2;
    }
  }
}

__device__ __forceinline__ void convert_experts(PR p, int l, unsigned char* smem) {
  float* T = (float*)smem;
  int* sidx = (int*)(smem + 70000);
  const int tid = otid();
  int nextt = (tid == 0) ? atomicAdd(&p.WQ[l], 4) : 0;
  for (;;) {
    __syncthreads();
    if (tid == 0) *sidx = nextt;
    __syncthreads();
    const int base = __builtin_amdgcn_readfirstlane(*sidx);
    if (base >= 256 * 48) break;
    if (tid == 0) nextt = atomicAdd(&p.WQ[l], 4);
  for (int it = base; it < base + 4; ++it) {
    const int e = it / 48, q = it % 48;
    const float* src; u16* dst; int ldn, K, k0, n0; bool gu;
    if (q < 32) { gu = true; k0 = (q >> 1) * 64; n0 = (q & 1) * 256; ldn = 512; K = 1024;
      src = p.exp_w_gu + ((size_t)l * 256 + e) * DM * 512; dst = p.EGU + (size_t)e * 512 * 1024; }
    else { const int q2 = q - 32; gu = false; k0 = (q2 >> 2) * 64; n0 = (q2 & 3) * 256; ldn = 1024; K = 256;
      src = p.exp_w_down + ((size_t)l * 256 + e) * 256 * DM; dst = p.EDN + (size_t)e * 1024 * 256; }
    const float* sp0 = src + (size_t)(k0 + (tid >> 6)) * ldn + n0 + (tid & 63) * 4;
#define NTL(P_) __builtin_nontemporal_load((const f32x4*)(P_))
    const f32x4 v0 = NTL(sp0), v1 = NTL(sp0 + (size_t)8 * ldn), v2 = NTL(sp0 + (size_t)16 * ldn), v3 = NTL(sp0 + (size_t)24 * ldn),
                v4 = NTL(sp0 + (size_t)32 * ldn), v5 = NTL(sp0 + (size_t)40 * ldn), v6 = NTL(sp0 + (size_t)48 * ldn), v7 = NTL(sp0 + (size_t)56 * ldn);
#undef NTL
    __syncthreads();
    float* tq = T + (tid >> 6) * 260 + (tid & 63) * 4;
    *(f32x4*)(tq) = v0; *(f32x4*)(tq + 8 * 260) = v1; *(f32x4*)(tq + 16 * 260) = v2; *(f32x4*)(tq + 24 * 260) = v3;
    *(f32x4*)(tq + 32 * 260) = v4; *(f32x4*)(tq + 40 * 260) = v5; *(f32x4*)(tq + 48 * 260) = v6; *(f32x4*)(tq + 56 * 260) = v7;
    __syncthreads();
#pragma unroll
    for (int i = 0; i < 4; ++i) {
      const int c = tid + 512 * i;
      const int n = c & 255, kc = c >> 8;
      const float* tp = T + (kc * 8) * 260 + n;
      uint4 o;
      o.x = pk2bf(tp[0], tp[260]); o.y = pk2bf(tp[2 * 260], tp[3 * 260]);
      o.z = pk2bf(tp[4 * 260], tp[5 * 260]); o.w = pk2bf(tp[6 * 260], tp[7 * 260]);
      const int col = n0 + n;
      int orow;
      if (gu) orow = (col < 256) ? ((col >> 4) * 32 + (col & 15)) : (((col - 256) >> 4) * 32 + 16 + (col & 15));
      else orow = col;
      *(uint4*)(dst + (size_t)orow * K + k0 + kc * 8) = o;
    }
  }
  }
}

__device__ __forceinline__ void phase_router(PR p, int l, unsigned char* smem) {
  const int tid = otid();
  const int nrows = (l == 0) ? NROW : NLAT;
  int* cnt = p.CNT + l * 256;
  float* LG = p.YO;
  for (int pm = blockIdx.x; pm < nrows / 256; pm += gridDim.x) {
    gemm256<false, false, 1>(p.HN, p.HLO, 32, DM, p.RWT + (size_t)l * 256 * 3072, 3072, pm * 256, 0, smem,
                   [&](int row, int col, const float4& v, const float4&) { *(float4*)(LG + (size_t)row * 256 + col) = v; });
    __syncthreads();
    {
      const int t2 = otid();
      const int lane = t2 & 63, w = t2 >> 6;
      const float4 rb = *(const float4*)(p.router_b + l * 256 + lane * 4);
      f32x4 lgn = __builtin_nontemporal_load((const f32x4*)(LG + (size_t)(pm * 256 + w) * 256 + lane * 4));
      int prow = 0, pmye = 0, ppos = 0;
      float pwv = 0.f;
      for (int rr = w; rr < 256; rr += 8) {
        const int row = pm * 256 + rr;
        const f32x4 lg_ = lgn;
        lgn = __builtin_nontemporal_load((const f32x4*)(LG + (size_t)(pm * 256 + min(rr + 8, 255)) * 256 + lane * 4));
        const float4 lg = make_float4(lg_[0], lg_[1], lg_[2], lg_[3]);
        const float s0 = sigmoidf_(lg.x), s1 = sigmoidf_(lg.y), s2 = sigmoidf_(lg.z), s3 = sigmoidf_(lg.w);
        float v0 = s0 + rb.x, v1 = s1 + rb.y, v2 = s2 + rb.z, v3 = s3 + rb.w;
        float m1 = fmaxf(fmaxf(v0, v1), fmaxf(v2, v3));
        float m2 = fmaxf(fmaxf(fminf(v0, v1), fminf(v2, v3)), fminf(fmaxf(v0, v1), fmaxf(v2, v3)));
#define RT_MERGE2(CTRL) { const float o1 = dppf<CTRL>(m1), o2 = dppf<CTRL>(m2); \
          const float n1 = fmaxf(m1, o1), n2 = fmaxf(fminf(m1, o1), fmaxf(m2, o2)); m1 = n1; m2 = n2; }
        RT_MERGE2(0xB1) RT_MERGE2(0x4E) RT_MERGE2(0x141)
#undef RT_MERGE2
        const float gsc = m1 + m2;
        const int g = lane >> 3;
        int rank = 0;
#pragma unroll
        for (int gp = 0; gp < 8; ++gp) {
          const float og = shu(gsc, gp * 8);
          rank += (og > gsc || (og == gsc && gp < g)) ? 1 : 0;
        }
        if (rank >= 4) { v0 = -INFINITY; v1 = -INFINITY; v2 = -INFINITY; v3 = -INFINITY; }
        int mye = 0;
        float wsel = 0.f;
#pragma unroll
        for (int k = 0; k < 8; ++k) {
          float bv = v0; int bi = lane * 4;
          if (v1 > bv) { bv = v1; bi = lane * 4 + 1; }
          if (v2 > bv) { bv = v2; bi = lane * 4 + 2; }
          if (v3 > bv) { bv = v3; bi = lane * 4 + 3; }
#define RT_AMX(CTRL) { const float ov = dppf<CTRL>(bv); const int oi = dppi<CTRL>(bi); \
            if (ov > bv || (ov == bv && oi < bi)) { bv = ov; bi = oi; } }
          RT_AMX(0xB1) RT_AMX(0x4E) RT_AMX(0x141) RT_AMX(0x140)
#undef RT_AMX
          {
            float fb = shu(bv, 0); int fi = __builtin_amdgcn_readlane(bi, 0);
#pragma unroll
            for (int k2 = 1; k2 < 4; ++k2) {
              const float ov = shu(bv, 16 * k2); const int oi = __builtin_amdgcn_readlane(bi, 16 * k2);
              if (ov > fb || (ov == fb && oi < fi)) { fb = ov; fi = oi; }
            }
            bv = fb; bi = fi;
          }
          if (bi == lane * 4 + 0) v0 = -INFINITY;
          if (bi == lane * 4 + 1) v1 = -INFINITY;
          if (bi == lane * 4 + 2) v2 = -INFINITY;
          if (bi == lane * 4 + 3) v3 = -INFINITY;
          if (lane == k) mye = bi;
          {
            const int sub_ = bi & 3;
            const float ssel = (sub_ == 0) ? s0 : (sub_ == 1 ? s1 : (sub_ == 2 ? s2 : s3));
            const float wk = shu(ssel, bi >> 2);
            if (lane == k) wsel = wk;
          }
        }
        const float wv = (lane < 8) ? wsel : 0.f;
        const float wsum = wave_sum(wv);
        if (rr != w && lane < 8) {
          p.LTOK[(size_t)pmye * CAP + ppos] = prow;
          p.LW[(size_t)pmye * CAP + ppos] = pwv;
          p.TOKSLOT[(size_t)prow * 8 + lane] = pmye * CAP + ppos;
        }
        if (lane < 8) ppos = atomicAdd(&cnt[mye], 1);
        prow = row; pmye = mye; pwv = wv * (2.5f / wsum);
      }
      if (lane < 8) {
        p.LTOK[(size_t)pmye * CAP + ppos] = prow;
        p.LW[(size_t)pmye * CAP + ppos] = pwv;
        p.TOKSLOT[(size_t)prow * 8 + lane] = pmye * CAP + ppos;
      }
    }
  }
  {
    const int nM = nrows / 256;
    int* sidx = (int*)(smem + 131072 + 2056);
    int nextt = (otid() == 0) ? atomicAdd(&p.WQ[4 + l], 1) : 0;
    for (;;) {
      __syncthreads();
      if (otid() == 0) *sidx = nextt;
      __syncthreads();
      const int it = __builtin_amdgcn_readfirstlane(*sidx);
      if (it >= nM * 2) break;
      if (otid() == 0) nextt = atomicAdd(&p.WQ[4 + l], 1);
      int pm, pn;
      g8_tile(it, nM, 2, pm, pn);
      u16* AS_ = p.ACTSH;
      gemm256<true, false, 1>(p.HN, p.HN, 1 << 30, DM, p.ShGuT + (size_t)l * 512 * 1024, DM, pm * 256, pn * 256, smem,
                    [&](int row, int ac, const float4& g, const float4& u) {
                      *(uint2*)(AS_ + (size_t)row * 256 + ac) = make_uint2(pk2bf(siluf_(g.x) * u.x, siluf_(g.y) * u.y), pk2bf(siluf_(g.z) * u.z, siluf_(g.w) * u.w));
                    });
    }
  }
  convert_experts(p, l, smem);
}

__device__ __forceinline__ int expert_offsets(const int* cnt, int* offs, int* tl) {
  __syncthreads();
  if (threadIdx.x < 256) tl[threadIdx.x] = cnt[threadIdx.x];
  __syncthreads();
  if (threadIdx.x == 0) {
    int o = 0, t = 0;
#pragma unroll 8
    for (int e = 0; e < 256; ++e) { const int c = tl[e]; offs[e] = o; tl[e] = t; o += c; t += (c + 255) >> 8; }
    offs[256] = o; tl[256] = t;
  }
  __syncthreads();
  return tl[256];
}
__device__ __forceinline__ int find_expert(const int* tl, int tile) {
  int lo = 0, hi = 255;
  while (lo < hi) { const int mid = (lo + hi + 1) >> 1; if (tl[mid] <= tile) lo = mid; else hi = mid - 1; }
  return lo;
}

__device__ __forceinline__ void phase_gu(PR p, int l, unsigned char* smem) {
  int* offs = (int*)(smem + 131072);
  int* tl = offs + 257;
  const int* cnt = p.CNT + l * 256;
  const int ntile = expert_offsets(cnt, offs, tl);
  {
    TileIter ti;
    for (int it = ti.next(ntile * 2); it >= 0; it = ti.next(ntile * 2)) {
      const int tile = it >> 1, nt = it & 1;
      const int e = __builtin_amdgcn_readfirstlane(find_expert(tl, tile));
      const int mt = tile - __builtin_amdgcn_readfirstlane(tl[e]);
      const int ce = __builtin_amdgcn_readfirstlane(cnt[e]);
      const int nvalid = min(256, ce - mt * 256);
      const int obase = __builtin_amdgcn_readfirstlane(offs[e]) + mt * 256;
      u16* ACT_ = p.ACT;
      const float* LW_ = p.LW + (size_t)e * CAP + mt * 256;
      gemm256<true, true, 1>(p.HN, p.HN, 1 << 30, DM, p.EGU + (size_t)e * 512 * 1024, DM, 0, nt * 256, smem,
                          [&](int row, int ac, const float4& g, const float4& u) {
                            if (row < nvalid) {
                              const float w_ = LW_[row];
                              *(uint2*)(ACT_ + (size_t)(obase + row) * 256 + ac) =
                                  make_uint2(pk2bf(siluf_(g.x) * u.x * w_, siluf_(g.y) * u.y * w_), pk2bf(siluf_(g.z) * u.z * w_, siluf_(g.w) * u.w * w_));
                            }
                          },
                          p.LTOK + (size_t)e * CAP + mt * 256, nvalid);
    }
  }
  {
    const int nM = ((l == 0) ? NROW : NLAT) / 256;
    int* sidx = (int*)(smem + 131072 + 2056);
    int nextt = (otid() == 0) ? atomicAdd(&p.WQ[2 + l], 1) : 0;
    for (;;) {
      __syncthreads();
      if (otid() == 0) *sidx = nextt;
      __syncthreads();
      const int it = __builtin_amdgcn_readfirstlane(*sidx);
      if (it >= nM * 4) break;
      if (otid() == 0) nextt = atomicAdd(&p.WQ[2 + l], 1);
      int pm, pn;
      g8_tile(it, nM, 4, pm, pn);
      u16* F_ = p.FSH;
      gemm256<false, false, 1>(p.ACTSH, p.ACTSH, 1 << 30, 256, p.ShDnT + (size_t)l * 1024 * 256, 256, pm * 256, pn * 256, smem,
                     [&](int row, int col, const float4& v, const float4&) {
                       *(uint2*)(F_ + (size_t)row * DM + col) = make_uint2(pk2bf(v.x, v.y), pk2bf(v.z, v.w));
                     });
    }
  }
}

__device__ __forceinline__ void phase_down(PR p, int l, unsigned char* smem) {
  int* offs = (int*)(smem + 131072);
  int* tl = offs + 257;
  const int* cnt = p.CNT + l * 256;
  const int ntile = expert_offsets(cnt, offs, tl);
  TileIter ti;
  for (int it = ti.next(ntile * 4); it >= 0; it = ti.next(ntile * 4)) {
    const int tile = it >> 2, nt = it & 3;
    const int e = __builtin_amdgcn_readfirstlane(find_expert(tl, tile));
    const int mt = tile - __builtin_amdgcn_readfirstlane(tl[e]);
    const int ce = __builtin_amdgcn_readfirstlane(cnt[e]);
    const int nvalid = min(256, ce - mt * 256);
    const int obase = __builtin_amdgcn_readfirstlane(offs[e]) + mt * 256;
    u16* YR_ = p.YR;
    gemm256<false, false, 1>(p.ACT, p.ACT, 1 << 30, 256, p.EDN + (size_t)e * 1024 * 256, 256, obase, nt * 256, smem,
                          [&](int row, int col, const float4& v, const float4&) {
                            if (row - obase < nvalid) *(uint2*)(YR_ + (size_t)row * DM + col) = make_uint2(pk2bf(v.x, v.y), pk2bf(v.z, v.w));
                          },
                          nullptr, nvalid);
  }
}

__device__ __forceinline__ void phase_post2(PR p, int l, unsigned char* smem) {
  int* offs = (int*)smem;
  int* tl = offs + 257;
  expert_offsets(p.CNT + l * 256, offs, tl);
  const int tid_ = otid();
  const int lane = tid_ & 63;
  const int gw = blockIdx.x * 8 + (tid_ >> 6), nw = gridDim.x * 8;
  const float* ng3 = p.norm_g + (l * 4 + 3) * DM;
  const int nrows = (l == 0) ? NROW : NLAT;
  int slot_next = (gw < nrows && lane < 8) ? p.TOKSLOT[(size_t)gw * 8 + lane] : 0;
  for (int r = gw; r < nrows; r += nw) {
    const float* mod = p.MOD + (l * 3 + mod_index(r)) * 6144;
    const int slotv = slot_next;
    if (r + nw < nrows && lane < 8) slot_next = p.TOKSLOT[(size_t)(r + nw) * 8 + lane];
    uint2 fb[4], yb[8][4];
#pragma unroll
    for (int q = 0; q < 4; ++q) { const u32x2v t_ = __builtin_nontemporal_load((const u32x2v*)(p.FSH + (size_t)r * DM + q * 256 + lane * 4)); fb[q] = make_uint2(t_.x, t_.y); }
#pragma unroll
    for (int k = 0; k < 8; ++k) {
      const int v = __builtin_amdgcn_readlane(slotv, k);
      const int e = v / CAP, pos = v - e * CAP;
      const u16* yr = p.YR + (size_t)(offs[e] + pos) * DM;
#pragma unroll
      for (int q = 0; q < 4; ++q) { const u32x2v t_ = __builtin_nontemporal_load((const u32x2v*)(yr + q * 256 + lane * 4)); yb[k][q] = make_uint2(t_.x, t_.y); }
    }
    float4 fv[4];
#pragma unroll
    for (int q = 0; q < 4; ++q) {
      fv[q] = make_float4(bf2f((u16)(fb[q].x & 0xFFFF)), bf2f((u16)(fb[q].x >> 16)), bf2f((u16)(fb[q].y & 0xFFFF)), bf2f((u16)(fb[q].y >> 16)));
#pragma unroll
      for (int k = 0; k < 8; ++k) {
        fv[q].x += bf2f((u16)(yb[k][q].x & 0xFFFF)); fv[q].y += bf2f((u16)(yb[k][q].x >> 16));
        fv[q].z += bf2f((u16)(yb[k][q].y & 0xFFFF)); fv[q].w += bf2f((u16)(yb[k][q].y >> 16));
      }
    }
    float ss = 0.f;
#pragma unroll
    for (int q = 0; q < 4; ++q) ss += fv[q].x * fv[q].x + fv[q].y * fv[q].y + fv[q].z * fv[q].z + fv[q].w * fv[q].w;
    ss = wave_sum(ss);
    const float rs = rsqrtf(ss * (1.f / DM) + EPSV);
    float s2 = 0.f;
#pragma unroll
    for (int q = 0; q < 4; ++q) {
      const int e = q * 256 + lane * 4;
      const float4 gv = *(const float4*)(ng3 + e);
      const float4 g2 = *(const float4*)(mod + 5120 + e);
      float4 xx = ldx4(p.X + (size_t)r * DM + e);
      xx.x += g2.x * (fv[q].x * rs * gv.x); xx.y += g2.y * (fv[q].y * rs * gv.y);
      xx.z += g2.z * (fv[q].z * rs * gv.z); xx.w += g2.w * (fv[q].w * rs * gv.w);
      if (l == 1) *(float4*)(p.out + (size_t)r * DM + e) = xx;
      else stx4(p.X + (size_t)r * DM + e, xx);
      fv[q] = xx;
      s2 += xx.x * xx.x + xx.y * xx.y + xx.z * xx.z + xx.w * xx.w;
    }
    if (l == 0) {
      s2 = wave_sum(s2);
      const float rs2 = rsqrtf(s2 * (1.f / DM) + EPSV);
      const float* gn = p.norm_g + (1 * 4 + 0) * DM;
      const float* mod1 = p.MOD + (1 * 3 + mod_index(r)) * 6144;
#pragma unroll
      for (int q = 0; q < 4; ++q) {
        const int e = q * 256 + lane * 4;
        const float4 gv = *(const float4*)(gn + e);
        const float4 sh = *(const float4*)(mod1 + e);
        const float4 sc = *(const float4*)(mod1 + 1024 + e);
        uint2 o;
        o.x = pk2bf(fv[q].x * rs2 * gv.x * (1.f + sc.x) + sh.x, fv[q].y * rs2 * gv.y * (1.f + sc.y) + sh.y);
        o.y = pk2bf(fv[q].z * rs2 * gv.z * (1.f + sc.z) + sh.z, fv[q].w * rs2 * gv.w * (1.f + sc.w) + sh.w);
        *(uint2*)(p.HN + (size_t)r * DM + e) = o;
      }
    }
  }
}

#define SMEM_BYTES (16384 * 8 + 256 * 8 + 64)

__device__ __forceinline__ void grid_barrier(PR p, unsigned char* smem) {
  XcdBarrier b;
  b.bar = p.bar; b.x = xb_xcc_id(); b.st = (volatile LAS unsigned*)(smem + SMEM_BYTES);
  xcd_barrier(b);
}

__global__ void __launch_bounds__(NTH, 2) k_fused(Params p_unused) {
  extern __shared__ __align__(16) unsigned char smem[];
  PR p = *(const __attribute__((address_space(4))) Params*)__builtin_amdgcn_kernarg_segment_ptr();
  uint4* xbw = (uint4*)(smem + SMEM_BYTES);
  if (threadIdx.x == 0) *xbw = make_uint4(0u, 0u, 0u, 0u);
  __syncthreads();
  (void)xcd_barrier_post(p.bar, (volatile LAS unsigned*)xbw);
  int* xinfo = (int*)(smem + XINFO_OFF);
  if (threadIdx.x == 0) xinfo[1] = (int)atomicAdd(p.bar + XCEN_WORD + xb_xcc_id(), 1u);
  phase_prologue(p, smem);
  grid_barrier(p, smem);
  if (threadIdx.x == 0) {
    const unsigned me = xb_xcc_id();
    unsigned nxp = 0, ord = 0, mine = 0, tot = 0; bool even = true;
    for (unsigned j = 0; j < 16; ++j) {
      const unsigned c = __hip_atomic_load(p.bar + XCEN_WORD + j, __ATOMIC_RELAXED, __HIP_MEMORY_SCOPE_AGENT);
      if (c) { ++nxp; if (j < me) ++ord; }
      if (j == me) mine = c;
      tot += c;
    }
    for (unsigned j = 0; j < 16; ++j) {
      const unsigned c = __hip_atomic_load(p.bar + XCEN_WORD + j, __ATOMIC_RELAXED, __HIP_MEMORY_SCOPE_AGENT);
      if (c && c != mine) even = false;
    }
    even = even && (tot == gridDim.x) && (mine > 0);
    xinfo[0] = (int)ord; xinfo[2] = even ? (int)mine : 0; xinfo[3] = (int)nxp;
  }
  __syncthreads();
#define LAYER_BODY(l) \
    if (l == 0) { phase_norm1(p, l); grid_barrier(p, smem); } \
    phase_inproj(p, l, smem); \
    grid_barrier(p, smem); \
    phase_mixA(p, l, smem); \
    grid_barrier(p, smem); \
    phase_scan(p, l); \
    grid_barrier(p, smem); \
    phase_mixC(p, l, smem); \
    grid_barrier(p, smem); \
    phase_outproj(p, l, smem); \
    grid_barrier(p, smem); \
    phase_post1(p, l); \
    grid_barrier(p, smem); \
    phase_router(p, l, smem); \
    grid_barrier(p, smem); \
    phase_gu(p, l, smem); \
    grid_barrier(p, smem); \
    phase_down(p, l, smem); \
    grid_barrier(p, smem); \
    phase_post2(p, l, smem); \
    grid_barrier(p, smem);
  LAYER_BODY(0)
  LAYER_BODY(1)
#undef LAYER_BODY
}

extern "C" void kernel_launch(void* const* d_in, const int* in_sizes, int n_in, void* d_out, int out_size, void* d_ws,
                              size_t ws_size, hipStream_t stream) {
  Params p{};
  const float* const* in = (const float* const*)d_in;
  p.x = in[0]; p.c = in[1]; p.ctx = in[2]; p.c_ctx = in[3]; p.ada_w = in[4]; p.ada_b = in[5]; p.norm_g = in[6];
  p.w_in = in[7]; p.w_out = in[8]; p.hy_conv_w = in[9]; p.hy_conv_b = in[10]; p.hy_w1 = in[11]; p.hy_b1 = in[12];
  p.hy_w2 = in[13]; p.hy_b2 = in[14]; p.hy_w3 = in[15]; p.hy_freq = in[16]; p.hy_bias = in[17]; p.hy_norm = in[18];
  p.hg_lb_logits = in[19]; p.hg_norm = in[20]; p.gla_a_up = in[21]; p.gla_a_b = in[22]; p.gla_norm = in[23];
  p.ml_conv_w = in[24]; p.ml_conv_b = in[25]; p.ml_gate_b = in[26]; p.ml_norm = in[27];
  p.router_w = in[28]; p.router_b = in[29]; p.exp_w_gu = in[30]; p.exp_w_down = in[31]; p.sh_w_gu = in[32]; p.sh_w_down = in[33];
  p.out = (float*)d_out;
  size_t off = 0;
  auto alloc = [&](size_t bytes) { void* r = (char*)d_ws + off; off += (bytes + 255) & ~(size_t)255; return r; };
  p.bar = (unsigned*)alloc(16384);
  p.X = (u16*)alloc((size_t)NROW * DM * 4);
  p.MOD = (float*)alloc(2 * 3 * 6144 * 4);
  p.LBv = (float*)alloc(2 * 256 * 4);
  p.HFT = (float*)alloc((size_t)2 * 1024 * 8192 * 4);
  p.HFTC = (float*)alloc((size_t)1024 * 256 * 4);
  p.PT = (u16*)alloc((size_t)768 * NROW * 4);
  p.HS = (uint32_t*)alloc((size_t)256 * 2 * 16384 * 8);
  p.ZS = (float2*)alloc((size_t)256 * 8192 * 8);
  p.HN = (u16*)alloc((size_t)NROW * DM * 2);
  p.P = (u16*)alloc((size_t)NROW * DIN * 4);
  p.YMIX = (u16*)alloc((size_t)NROW * DM * 2);
  p.YO = (float*)alloc((size_t)NROW * DM * 4);
  p.HYRAW = (float*)alloc((size_t)NROW * 256 * 4);
  p.SBHG = (u16*)alloc((size_t)16 * NCH * 4096 * 2);
  p.SBGL = (u16*)alloc((size_t)16 * NCH * 2048 * 2);
  p.SBML = (u16*)alloc((size_t)16 * NCH * 4096 * 2);
  p.NBML = (float*)alloc((size_t)16 * NCH * 64 * 4);
  p.DCHG = (float*)alloc((size_t)16 * NCH * 64 * 4);
  p.DCGL = (float*)alloc((size_t)16 * NCH * 32 * 4);
  p.DCML = (float*)alloc((size_t)16 * NCH * 64 * 4);
  p.CNT = (int*)alloc(2 * 256 * 4);
  p.WQ = (int*)alloc(256);
  p.LTOK = (int*)alloc((size_t)256 * CAP * 4);
  p.LW = (float*)alloc((size_t)256 * CAP * 4);
  p.TOKSLOT = (int*)alloc((size_t)NROW * 8 * 4);
  p.ACT = (u16*)alloc((size_t)(NSLOT + 512) * 256 * 2);
  p.ACTSH = (u16*)alloc((size_t)NROW * 256 * 2);
  p.FSH = (u16*)alloc((size_t)NROW * DM * 2);
  p.YOB = (u16*)alloc((size_t)NROW * DM * 2);
  p.YR = (u16*)alloc((size_t)(NSLOT + 512) * DM * 2);
  p.WinT = (u16*)alloc((size_t)2 * 4096 * 1024 * 2);
  p.WoutT = (u16*)alloc((size_t)2 * 1024 * 1024 * 2);
  p.ShGuT = (u16*)alloc((size_t)2 * 512 * 1024 * 2);
  p.ShDnT = (u16*)alloc((size_t)2 * 1024 * 256 * 2);
  p.RWT = (u16*)alloc((size_t)2 * 256 * 3072 * 2);
  p.HLO = (u16*)alloc((size_t)NROW * DM * 2);
  p.EGU = (u16*)alloc((size_t)256 * 512 * 1024 * 2);
  p.EDN = (u16*)alloc((size_t)256 * 1024 * 256 * 2);
  if (off > ws_size) { fprintf(stderr, "workspace too small: need %zu have %zu\n", off, ws_size); return; }
  static int grid = 0;
  const size_t dyn = SMEM_BYTES + 16 + 64;
  if (!grid) {
    int dev = 0, cus = 0, per_cu = 0;
    hipGetDevice(&dev);
    hipDeviceGetAttribute(&cus, hipDeviceAttributeMultiprocessorCount, dev);
    (void)hipFuncSetAttribute((const void*)k_fused, hipFuncAttributeMaxDynamicSharedMemorySize, (int)dyn);
    (void)hipOccupancyMaxActiveBlocksPerMultiprocessor(&per_cu, k_fused, NTH, dyn);
    if (per_cu < 1) { fprintf(stderr, "occupancy query says 0 blocks per CU\n"); per_cu = 1; }
    grid = cus;
  }
  (void)hipMemsetAsync(p.bar, 0, 4096 * sizeof(unsigned), stream);
  hipLaunchKernelGGL(k_fused, dim3(grid), dim3(NTH), dyn, stream, p);
}
```

```cpp
#include <hip/hip_runtime.h>
#include <stdint.h>
#include <stdio.h>

#ifndef FUSED
#define FUSED 0
#endif

typedef unsigned short u16;
typedef __attribute__((ext_vector_type(8))) short bf16x8;
typedef __attribute__((ext_vector_type(4))) float f32x4;
typedef float f32x8v __attribute__((ext_vector_type(8)));
typedef float f32x16v __attribute__((ext_vector_type(16)));
typedef __attribute__((ext_vector_type(2))) unsigned u32x2v;
typedef __attribute__((ext_vector_type(16))) unsigned u32x16v;
typedef __attribute__((ext_vector_type(2))) float f32x2v;

#define XB_TMO      128
#define XB_XCNT(j)  (256  + 64 * (j))
#define XB_XSUB(j)  (1280 + 64 * (j))
#define XB_XGEN(j)  (2304 + 64 * (j))
#define XB_TOP      3328
#define XB_TOPGEN   3392
#define XCD_BAR_WORDS 3456
#define XB_SPIN_CAP (1u << 18)
#define LAS __attribute__((address_space(3)))

__device__ __forceinline__ unsigned xb_ld(unsigned* p)              { return __hip_atomic_load(p, __ATOMIC_RELAXED, __HIP_MEMORY_SCOPE_AGENT); }
__device__ __forceinline__ unsigned xb_add(unsigned* p, unsigned v) { return __hip_atomic_fetch_add(p, v, __ATOMIC_RELAXED, __HIP_MEMORY_SCOPE_AGENT); }
__device__ __forceinline__ unsigned xb_xcc_id() { return (unsigned)__builtin_amdgcn_s_getreg((3 << 11) | 20) & 0xFu; }
#define XB_SPIN(cond, bar) do { unsigned _sp = 0; while (cond) { __builtin_amdgcn_s_sleep(1); \
    if ((++_sp & 255u) == 0u) { if (xb_ld(&(bar)[XB_TMO])) break; if (_sp > XB_SPIN_CAP) { atomicAdd(&(bar)[XB_TMO], 1u); break; } } } } while (0)

struct XcdBarrier {
    unsigned* bar; unsigned x;
    volatile LAS unsigned* st;
};

__device__ __forceinline__ XcdBarrier xcd_barrier_post(unsigned* bar, volatile LAS unsigned* st) {
    XcdBarrier b; b.bar = bar; b.x = xb_xcc_id(); b.st = st;
    if (threadIdx.x == 0) (void)xb_add(&bar[XB_XCNT(b.x)], 1u);
    return b;
}
__device__ __forceinline__ void xcd_barrier_complete(unsigned* bar, unsigned x, unsigned& nloc, unsigned& nx) {
    const unsigned G = gridDim.x * gridDim.y * gridDim.z;
    unsigned sum, cnt, mine, sp = 0u;
    for (;;) {
        sum = 0u; cnt = 0u; mine = 0u;
#pragma unroll
        for (unsigned j = 0; j < 16; ++j) { const unsigned c = xb_ld(&bar[XB_XCNT(j)]); sum += c; cnt += (c > 0u) ? 1u : 0u; mine = (j == x) ? c : mine; }
        if (sum == G) break;
        __builtin_amdgcn_s_sleep(1);
        if ((++sp & 255u) == 0u) { if (xb_ld(&bar[XB_TMO])) break; if (sp > XB_SPIN_CAP) { atomicAdd(&bar[XB_TMO], 1u); break; } }
    }
    nloc = mine > 0u ? mine : 1u; nx = cnt > 0u ? cnt : 1u;
}

__device__ __forceinline__ void xcd_barrier(const XcdBarrier& b) {
    asm volatile("s_waitcnt vmcnt(0)" ::: "memory");
    __syncthreads();
    if (threadIdx.x == 0) {
        unsigned* bar = b.bar;
        __builtin_amdgcn_s_waitcnt(0);
        unsigned nloc = b.st[0], nx = b.st[1];
        if (nloc == 0u) { xcd_barrier_complete(bar, b.x, nloc, nx); b.st[0] = nloc; b.st[1] = nx; }
        const unsigned old = xb_add(&bar[XB_XSUB(b.x)], 1u);
        const unsigned gen = old / nloc;
        if (old + 1u == (gen + 1u) * nloc) {
            __builtin_amdgcn_fence(__ATOMIC_RELEASE, "agent");
            asm volatile("s_waitcnt vmcnt(0)" ::: "memory");
            const unsigned og = xb_add(&bar[XB_TOP], 1u);
            const unsigned tg = og / nx;
            if (og + 1u == (tg + 1u) * nx) xb_add(&bar[XB_TOPGEN], 1u);
            else XB_SPIN(xb_ld(&bar[XB_TOPGEN]) == tg, bar);
            __builtin_amdgcn_fence(__ATOMIC_ACQUIRE, "agent");
            xb_add(&bar[XB_XGEN(b.x)], 1u);
            asm volatile("s_waitcnt vmcnt(0)" ::: "memory");
        } else {
            XB_SPIN(xb_ld(&bar[XB_XGEN(b.x)]) == gen, bar);
            __builtin_amdgcn_fence(__ATOMIC_ACQUIRE, "agent");
            asm volatile("s_waitcnt vmcnt(0)" ::: "memory");
        }
    }
    __syncthreads();
}


#define DM 1024
#define SEQL 8192
#define CTXL 256
#define NLAT 16384
#define NCTXR 512
#define NROW 16896
#define DIN 3888
#define NTH 512
#define NCH 132
#define CAP 16896
#define NSLOT (NROW * 8)
#define EPSV 1e-6f

struct Params {
  const float *x, *c, *ctx, *c_ctx, *ada_w, *ada_b, *norm_g, *w_in, *w_out;
  const float *hy_conv_w, *hy_conv_b, *hy_w1, *hy_b1, *hy_w2, *hy_b2, *hy_w3, *hy_freq, *hy_bias, *hy_norm;
  const float *hg_lb_logits, *hg_norm, *gla_a_up, *gla_a_b, *gla_norm;
  const float *ml_conv_w, *ml_conv_b, *ml_gate_b, *ml_norm;
  const float *router_w, *router_b, *exp_w_gu, *exp_w_down, *sh_w_gu, *sh_w_down;
  float* out;
  unsigned* bar;
  u16* X;
  float* MOD;
  float* LBv;
  float* HFT;
  float* HFTC;
  u16* PT;
  uint32_t* HS;
  float2* ZS;
  u16* HN;
  u16* P;
  u16* YMIX;
  float* YO;
  float* HYRAW;
  u16* SBHG;
  u16* SBGL;
  u16* SBML;
  float* NBML;
  float* DCHG;
  float* DCGL;
  float* DCML;
  int* CNT;
  int* WQ;
  int* LTOK;
  float* LW;
  int* TOKSLOT;
  u16* ACT;
  u16* ACTSH;
  u16* FSH;
  u16* YOB;
  u16* YR;
  u16* WinT;
  u16* WoutT;
  u16* ShGuT;
  u16* ShDnT;
  u16* RWT;
  u16* HLO;
  u16* EGU;
  u16* EDN;
};

typedef const __attribute__((address_space(4))) Params& PR;
__device__ __forceinline__ int otid() { int t = threadIdx.x; asm volatile("" : "+v"(t)); return t; }
typedef __bf16 bf16x2_t __attribute__((ext_vector_type(2)));
typedef float float2_t __attribute__((ext_vector_type(2)));
__device__ __forceinline__ uint32_t pk2bf(float a, float b) {
  float2_t v = {a, b};
  bf16x2_t r = __builtin_convertvector(v, bf16x2_t);
  return *(uint32_t*)&r;
}
__device__ __forceinline__ u16 f2bf(float f) { return (u16)(pk2bf(f, 0.f) & 0xFFFFu); }
__device__ __forceinline__ float bf2f(u16 h) { return __uint_as_float(((uint32_t)h) << 16); }
__device__ __forceinline__ float sigmoidf_(float z) { return 1.f / (1.f + expf(-z)); }
__device__ __forceinline__ float siluf_(float z) { return z / (1.f + expf(-z)); }
__device__ __forceinline__ float logsigmoidf_(float z) { return (z >= 0.f) ? -log1pf(expf(-z)) : (z - log1pf(expf(z))); }
__device__ __forceinline__ float fexp(float x) { return __expf(x); }
__device__ __forceinline__ float frcp(float x) { return __builtin_amdgcn_rcpf(x); }
__device__ __forceinline__ float fsigmoid(float z) { return frcp(1.f + __expf(-z)); }
__device__ __forceinline__ float fsilu(float z) { return z * frcp(1.f + __expf(-z)); }
__device__ __forceinline__ float flogsigmoid(float z) { return fminf(z, 0.f) - __logf(1.f + __expf(-fabsf(z))); }
__device__ __forceinline__ int olane() {
  int l = (int)__builtin_amdgcn_mbcnt_hi(~0u, __builtin_amdgcn_mbcnt_lo(~0u, 0u));
  asm volatile("" : "+v"(l));
  return l;
}
__device__ __forceinline__ float shx(float v, int m, int lane) { return __int_as_float(__builtin_amdgcn_ds_bpermute((lane ^ m) << 2, __float_as_int(v))); }
__device__ __forceinline__ int shxi(int v, int m, int lane) { return __builtin_amdgcn_ds_bpermute((lane ^ m) << 2, v); }
__device__ __forceinline__ float shl_(float v, int src) { return __int_as_float(__builtin_amdgcn_ds_bpermute(src << 2, __float_as_int(v))); }
__device__ __forceinline__ float shu(float v, int src) { return __int_as_float(__builtin_amdgcn_readlane(__float_as_int(v), src)); }
template <int CTRL> __device__ __forceinline__ int dppi(int v) { return __builtin_amdgcn_update_dpp(0, v, CTRL, 0xF, 0xF, false); }
template <int CTRL> __device__ __forceinline__ float dppf(float v) {
  return __int_as_float(__builtin_amdgcn_update_dpp(0, __float_as_int(v), CTRL, 0xF, 0xF, false));
}
__device__ __forceinline__ float wave_sum(float v) {
  v += dppf<0xB1>(v);
  v += dppf<0x4E>(v);
  v += dppf<0x141>(v);
  v += dppf<0x140>(v);
  return (shu(v, 0) + shu(v, 16)) + (shu(v, 32) + shu(v, 48));
}
__device__ __forceinline__ float block_sum(float v, float* red) {
  v = wave_sum(v);
  __syncthreads();
  if ((threadIdx.x & 63) == 0) red[threadIdx.x >> 6] = v;
  __syncthreads();
  float s = 0.f;
#pragma unroll
  for (int i = 0; i < 8; ++i) s += red[i];
  return s;
}

#define G2_LD 40
struct GemmSmem { u16 As[2][128 * G2_LD]; u16 Bs[2][256 * G2_LD]; };

template <class BCOL>
__device__ __forceinline__ void gemm_tile(const u16* arow, const float* __restrict__ B, int ldb, const BCOL& bcol, int K,
                                          GemmSmem* sm, f32x4 (&acc)[4][4]) {
  const int tid = otid(), lane = tid & 63, w = tid >> 6, wm = w >> 2, wn = w & 3;
#pragma unroll
  for (int i = 0; i < 4; ++i)
#pragma unroll
    for (int j = 0; j < 4; ++j) acc[i][j] = (f32x4){0.f, 0.f, 0.f, 0.f};
  const int akc = tid & 3, ar = tid >> 2;
  const int kg = tid & 7, ng = tid >> 3;
  const int bc = bcol(ng * 4);
  const float* bp = B + (size_t)(kg * 4) * ldb + bc;
  const u16* ap = arow + akc * 8;
  uint4 ra0, ra1, ra2, ra3;
  float4 rb00, rb01, rb02, rb03, rb10, rb11, rb12, rb13, rb20, rb21, rb22, rb23, rb30, rb31, rb32, rb33;
  const int nk = K >> 5;
#define G2_RB(S, J) rb##S##J
#define G2_LOAD(S, KT)                                                   \
  {                                                                      \
    ra##S = *(const uint4*)(ap + (KT) * 32);                             \
    G2_RB(S, 0) = *(const float4*)(bp + (size_t)((KT) * 32 + 0) * ldb);     \
    G2_RB(S, 1) = *(const float4*)(bp + (size_t)((KT) * 32 + 1) * ldb);     \
    G2_RB(S, 2) = *(const float4*)(bp + (size_t)((KT) * 32 + 2) * ldb);     \
    G2_RB(S, 3) = *(const float4*)(bp + (size_t)((KT) * 32 + 3) * ldb);     \
  }
#define G2_STORE(S, BUF)                                                                                                     \
  {                                                                                                                          \
    *(uint4*)(&sm->As[BUF][ar * G2_LD + akc * 8]) = ra##S;                                                                   \
    *(uint2*)(&sm->Bs[BUF][(ng * 4 + 0) * G2_LD + kg * 4]) = make_uint2(pk2bf(G2_RB(S, 0).x, G2_RB(S, 1).x), pk2bf(G2_RB(S, 2).x, G2_RB(S, 3).x)); \
    *(uint2*)(&sm->Bs[BUF][(ng * 4 + 1) * G2_LD + kg * 4]) = make_uint2(pk2bf(G2_RB(S, 0).y, G2_RB(S, 1).y), pk2bf(G2_RB(S, 2).y, G2_RB(S, 3).y)); \
    *(uint2*)(&sm->Bs[BUF][(ng * 4 + 2) * G2_LD + kg * 4]) = make_uint2(pk2bf(G2_RB(S, 0).z, G2_RB(S, 1).z), pk2bf(G2_RB(S, 2).z, G2_RB(S, 3).z)); \
    *(uint2*)(&sm->Bs[BUF][(ng * 4 + 3) * G2_LD + kg * 4]) = make_uint2(pk2bf(G2_RB(S, 0).w, G2_RB(S, 1).w), pk2bf(G2_RB(S, 2).w, G2_RB(S, 3).w)); \
  }
#define G2_COMPUTE(BUF)                                                                                                      \
  {                                                                                                                          \
    bf16x8 a_[4], b_[4];                                                                                                     \
    _Pragma("unroll") for (int i = 0; i < 4; ++i) a_[i] = *(const bf16x8*)(&sm->As[BUF][(wm * 64 + i * 16 + (lane & 15)) * G2_LD + (lane >> 4) * 8]); \
    _Pragma("unroll") for (int j = 0; j < 4; ++j) b_[j] = *(const bf16x8*)(&sm->Bs[BUF][(wn * 64 + j * 16 + (lane & 15)) * G2_LD + (lane >> 4) * 8]); \
    _Pragma("unroll") for (int i = 0; i < 4; ++i)                                                                            \
      _Pragma("unroll") for (int j = 0; j < 4; ++j) acc[i][j] = __builtin_amdgcn_mfma_f32_16x16x32_bf16(a_[i], b_[j], acc[i][j], 0, 0, 0); \
  }
#define G2_STEP(U, UN, BUF, BUFN)                      \
  {                                                    \
    const int kt = kt0 + U;                            \
    if (kt + 4 < nk) G2_LOAD(U, kt + 4)                \
    G2_COMPUTE(BUF)                                    \
    if (kt + 1 < nk) G2_STORE(UN, BUFN)                \
    __syncthreads();                                   \
  }
  G2_LOAD(0, 0) G2_LOAD(1, 1) G2_LOAD(2, 2) G2_LOAD(3, 3)
  __syncthreads();
  G2_STORE(0, 0)
  __syncthreads();
  for (int kt0 = 0; kt0 < nk; kt0 += 4) {
    G2_STEP(0, 1, 0, 1)
    G2_STEP(1, 2, 1, 0)
    G2_STEP(2, 3, 0, 1)
    G2_STEP(3, 0, 1, 0)
  }
#undef G2_LOAD
#undef G2_RB
#undef G2_STORE
#undef G2_COMPUTE
#undef G2_STEP
}

#define XINFO_OFF (16384 * 8 + 256 * 8 + 64 + 16)
#define XCEN_WORD 3600
struct TileIter {
  int G, cs, nx, xo, rk, round;
  __device__ __forceinline__ TileIter() : G(gridDim.x), round(0) {
    extern __shared__ __align__(16) unsigned char smem_ti[];
    const int* xi = (const int*)(smem_ti + XINFO_OFF);
    xo = __builtin_amdgcn_readfirstlane(xi[0]); rk = __builtin_amdgcn_readfirstlane(xi[1]);
    cs = __builtin_amdgcn_readfirstlane(xi[2]); nx = __builtin_amdgcn_readfirstlane(xi[3]);
  }
  __device__ __forceinline__ int next(int ntiles) { return __builtin_amdgcn_readfirstlane(next_(ntiles)); }
  __device__ __forceinline__ int next_(int ntiles) {
    for (;;) {
      if (cs == 0) { const int t = blockIdx.x + round * G; ++round; return t < ntiles ? t : -1; }
      const int chunk = round * nx + xo;
      ++round;
      if (chunk * cs >= ntiles) {
        if ((round - 1) * nx * cs >= ntiles) return -1;
        continue;
      }
      const int t = chunk * cs + rk;
      if (t < ntiles) return t;
    }
  }
};

#define G8_HT (128 * 64)
__device__ __forceinline__ int g8_lds_byte(int r, int c) {
  int st = (r >> 4) * 2 + (c >> 5), rr = r & 15, cc = c & 31, ob = rr * 64 + cc * 2;
  return st * 1024 + (ob ^ (((ob >> 9) & 1) << 5));
}
__device__ __forceinline__ void g8_stage_rc(int b, int& R, int& C) {
  int st = b / 1024, sb = b % 1024, swz = sb ^ (((sb >> 9) & 1) << 5);
  R = (st >> 1) * 16 + swz / 64; C = (st & 1) * 32 + (swz % 64) / 2;
}
template <bool PAIR, bool GATHER, int STG, class EPI>
__device__ __forceinline__ void gemm256(const u16* A, const u16* A2, int kswitch, int lda, const u16* Bt, int K, int brow, int bcol,
                                        unsigned char* smem, const EPI& epi, const int* rowtab = nullptr, int nvalid = 256, int nvalidB = 256) {
  const int amask = (lda >> 6) - 1;
  const bool hiv = nvalid > 128;
  const bool hjv = nvalidB > 128;
  int go00 = 0, go01 = 0, go10 = 0, go11 = 0;
  if (GATHER) {
    const int t0 = otid();
    int r0_, r1_, c_;
    g8_stage_rc(t0 * 16, r0_, c_);
    g8_stage_rc(t0 * 16 + 8192, r1_, c_);
    go00 = rowtab[(r0_ < nvalid) ? r0_ : 0] * lda;
    go01 = rowtab[(r1_ < nvalid) ? r1_ : 0] * lda;
    go10 = rowtab[(128 + r0_ < nvalid) ? 128 + r0_ : 0] * lda;
    go11 = rowtab[(128 + r1_ < nvalid) ? 128 + r1_ : 0] * lda;
  }
  u16* shm = (u16*)smem;
#define G8_SA(b, h) (shm + ((b) * 2 + (h)) * G8_HT)
#define G8_SB(b, h) (shm + (4 + (b) * 2 + (h)) * G8_HT)
#define G8_STAGE_B(T, P, BASE, br, kt) do { long _g = (long)(br) * K + (long)(kt) * 64; \
    for (int _i = 0; _i < 2; ++_i) { int _b = (T) * 16 + _i * 8192; int _r, _c; g8_stage_rc(_b, _r, _c); \
      __builtin_amdgcn_global_load_lds((const unsigned*)(BASE + _g + (long)_r * K + _c), \
        (LAS unsigned*)((char*)(P) + _b), 16, 0, 0); } } while (0)
#define G8_STAGE_A(T, P, BASE, br, kt) do { const u16* _ab = ((kt) < kswitch) ? A : A2; long _g = (long)((kt) & amask) * 64; \
    const int _h = ((br) - brow) >> 7; \
    for (int _i = 0; _i < 2; ++_i) { int _b = (T) * 16 + _i * 8192; int _r, _c; g8_stage_rc(_b, _r, _c); \
      const long _ro = GATHER ? (long)(_h == 0 ? (_i == 0 ? go00 : go01) : (_i == 0 ? go10 : go11)) : ((long)(br) + _r) * lda; \
      __builtin_amdgcn_global_load_lds((const unsigned*)(_ab + _g + _ro + _c), \
        (LAS unsigned*)((char*)(P) + _b), 16, 0, 0); } } while (0)
#define G8_STAGE_X(T, P, BASE, br, kt) G8_STAGE_##BASE(T, P, BASE, br, kt)
#define G8_STAGE_Bt G8_STAGE_B
#define G8_STAGE(P, BASE, br, kt) G8_STAGE_X(tx, P, BASE, br, kt)
#define G8_LDA(dst, b, h) for (int m = 0; m < 4; ++m) for (int k = 0; k < 2; ++k) \
    dst[m][k] = *reinterpret_cast<const bf16x8*>((char*)G8_SA(b, h) + g8_lds_byte(wr * 64 + m * 16 + fr, k * 32 + fq * 8))
#define G8_LDB(dst, b, h) for (int n = 0; n < 2; ++n) for (int k = 0; k < 2; ++k) \
    dst[n][k] = *reinterpret_cast<const bf16x8*>((char*)G8_SB(b, h) + g8_lds_byte(wc * 32 + n * 16 + fr, k * 32 + fq * 8))
#define G8_MMA(ai, bj, At, Bt_) do { __builtin_amdgcn_s_setprio(1); \
    for (int m = 0; m < 4; ++m) for (int n = 0; n < 2; ++n) for (int k = 0; k < 2; ++k) \
      acc[ai][bj][m][n] = __builtin_amdgcn_mfma_f32_16x16x32_bf16(At[m][k], Bt_[n][k], acc[ai][bj][m][n], 0, 0, 0); \
    __builtin_amdgcn_s_setprio(0); } while (0)
#define G8_WAIT_V(n) asm volatile("s_waitcnt vmcnt(" #n ")" ::: "memory")
#define G8_WAIT_L(n) asm volatile("s_waitcnt lgkmcnt(" #n ")" ::: "memory")
#define G8_BAR __builtin_amdgcn_s_barrier()
#define G8_SCHED __builtin_amdgcn_sched_barrier(0)
  int tx = otid();
  int wid = tx >> 6, lane = tx & 63, wr = wid >> 2, wc = wid & 3, fr = lane & 15, fq = lane >> 4;
  f32x4 acc[2][2][4][2] = {};
  bf16x8 At[4][2], B0[2][2], B1[2][2];
  const int nt = K / 64;
  G8_WAIT_V(0); G8_WAIT_L(0);
  __syncthreads();
  G8_STAGE(G8_SB(0, 0), Bt, bcol, 0); G8_STAGE(G8_SA(0, 0), A, brow, 0);
  G8_STAGE(G8_SB(0, 1), Bt, bcol + 128, 0); G8_STAGE(G8_SA(0, 1), A, brow + 128, 0);
  if (wr == 1) G8_BAR;
  G8_WAIT_V(4); G8_BAR;
  G8_STAGE(G8_SB(1, 0), Bt, bcol, 1); G8_STAGE(G8_SA(1, 0), A, brow, 1); G8_STAGE(G8_SB(1, 1), Bt, bcol + 128, 1);
  G8_WAIT_V(6); G8_BAR;
  for (int t = 0; t < nt - 2; t += 2) {
    G8_LDB(B0, 0, 0); G8_SCHED; G8_LDA(At, 0, 0); G8_STAGE(G8_SA(1, 1), A, brow + 128, t + 1);
    G8_WAIT_L(8); G8_BAR; G8_WAIT_L(0); G8_MMA(0, 0, At, B0); G8_BAR; G8_SCHED;
    G8_LDB(B1, 0, 1); G8_STAGE(G8_SB(0, 0), Bt, bcol, t + 2);
    G8_BAR; G8_WAIT_L(0); if (hjv) G8_MMA(0, 1, At, B1); G8_BAR;
    G8_LDA(At, 0, 1); G8_STAGE(G8_SA(0, 0), A, brow, t + 2);
    G8_BAR; G8_WAIT_L(0); if (hiv) G8_MMA(1, 0, At, B0); G8_BAR; G8_SCHED;
    G8_STAGE(G8_SB(0, 1), Bt, bcol + 128, t + 2);
    G8_WAIT_V(6); G8_BAR; if (hiv && hjv) G8_MMA(1, 1, At, B1); G8_BAR;
    G8_LDB(B0, 1, 0); G8_SCHED; G8_LDA(At, 1, 0); G8_STAGE(G8_SA(0, 1), A, brow + 128, t + 2);
    G8_WAIT_L(8); G8_BAR; G8_WAIT_L(0); G8_MMA(0, 0, At, B0); G8_BAR; G8_SCHED;
    G8_LDB(B1, 1, 1); G8_STAGE(G8_SB(1, 0), Bt, bcol, t + 3);
    G8_BAR; G8_WAIT_L(0); if (hjv) G8_MMA(0, 1, At, B1); G8_BAR;
    G8_LDA(At, 1, 1); G8_STAGE(G8_SA(1, 0), A, brow, t + 3);
    G8_BAR; G8_WAIT_L(0); if (hiv) G8_MMA(1, 0, At, B0); G8_BAR; G8_SCHED;
    G8_STAGE(G8_SB(1, 1), Bt, bcol + 128, t + 3);
    G8_WAIT_V(6); G8_BAR; if (hiv && hjv) G8_MMA(1, 1, At, B1); G8_BAR;
  }
  int tz = otid(); wid = tz >> 6; lane = tz & 63; wr = wid >> 2; wc = wid & 3; fr = lane & 15; fq = lane >> 4;
  { G8_LDB(B0, 0, 0); G8_WAIT_V(0); G8_LDA(At, 0, 0); G8_STAGE_X(tz, G8_SA(1, 1), A, brow + 128, nt - 1);
    G8_BAR; G8_WAIT_L(0); G8_MMA(0, 0, At, B0); G8_BAR;
    G8_LDB(B1, 0, 1); G8_BAR; G8_WAIT_L(0); if (hjv) G8_MMA(0, 1, At, B1); G8_BAR;
    G8_LDA(At, 0, 1); G8_WAIT_V(4); G8_BAR; G8_WAIT_L(0); if (hiv) G8_MMA(1, 0, At, B0); if (hiv && hjv) G8_MMA(1, 1, At, B1); G8_BAR; }
  { G8_LDB(B0, 1, 0); G8_LDA(At, 1, 0); G8_WAIT_V(2); G8_BAR; G8_WAIT_L(0); G8_MMA(0, 0, At, B0); G8_BAR;
    G8_LDB(B1, 1, 1); G8_WAIT_V(0); G8_BAR; G8_WAIT_L(0); if (hjv) G8_MMA(0, 1, At, B1); G8_BAR;
    G8_LDA(At, 1, 1); G8_BAR; G8_WAIT_L(0); if (hiv) G8_MMA(1, 0, At, B0); if (hiv && hjv) G8_MMA(1, 1, At, B1); G8_BAR; }
  if (wr == 0) G8_BAR;
  if constexpr (STG == 0) {
#pragma unroll
    for (int ai = 0; ai < 2; ++ai)
#pragma unroll
      for (int bj = 0; bj < 2; ++bj)
#pragma unroll
        for (int m = 0; m < 4; ++m) {
          const int row0 = brow + ai * 128 + wr * 64 + m * 16 + fq * 4, col = bcol + bj * 128 + wc * 32 + fr;
          if constexpr (PAIR) epi(row0, col, acc[ai][bj][m][0], acc[ai][bj][m][1]);
          else { epi(row0, col, acc[ai][bj][m][0], acc[ai][bj][m][0]); epi(row0, col + 16, acc[ai][bj][m][1], acc[ai][bj][m][1]); }
        }
  } else {
    float* T = (float*)smem;
#pragma unroll
    for (int ai = 0; ai < 2; ++ai) {
      if (ai == 1 && !hiv) break;
      __syncthreads();
#pragma unroll
      for (int bj = 0; bj < 2; ++bj)
#pragma unroll
        for (int m = 0; m < 4; ++m)
#pragma unroll
          for (int n = 0; n < 2; ++n)
#pragma unroll
            for (int r = 0; r < 4; ++r) {
              const int row = wr * 64 + m * 16 + fq * 4 + r, col = bj * 128 + wc * 32 + n * 16 + fr;
              T[row * 256 + (col ^ ((fq & 1) << 4))] = acc[ai][bj][m][n][r];
            }
      __syncthreads();
      if constexpr (!PAIR) {
#pragma unroll 4
        for (int i = 0; i < 16; ++i) {
          const int row = wid + 8 * i;
          const float4 v = *(const float4*)(T + row * 256 + ((lane * 4) ^ (((row >> 2) & 1) << 4)));
          epi(brow + ai * 128 + row, bcol + lane * 4, v, v);
        }
      } else {
#pragma unroll 4
        for (int i = 0; i < 8; ++i) {
          const int row = wid * 2 + (lane >> 5) + 16 * i;
          const int j = lane & 31, blk = j >> 2, q = j & 3;
          const int sw = ((row >> 2) & 1) << 4;
          const float4 vg = *(const float4*)(T + row * 256 + ((blk * 32 + q * 4) ^ sw));
          const float4 vu = *(const float4*)(T + row * 256 + ((blk * 32 + 16 + q * 4) ^ sw));
          epi(brow + ai * 128 + row, (bcol >> 1) + blk * 16 + q * 4, vg, vu);
        }
      }
    }
  }
#undef G8_SA
#undef G8_SB
#undef G8_STAGE_X
#undef G8_STAGE_A
#undef G8_STAGE_B
#undef G8_STAGE_Bt
#undef G8_STAGE
#undef G8_LDA
#undef G8_LDB
#undef G8_MMA
#undef G8_WAIT_V
#undef G8_WAIT_L
#undef G8_BAR
#undef G8_SCHED
}
__device__ __forceinline__ void g8_tile(int t, int nM, int nN, int& pm, int& pn) {
  const int nig = 8 * nN, gid = t / nig, fm = gid * 8, gsz = min(nM - fm, 8);
  pm = fm + ((t % nig) % gsz); pn = (t % nig) / gsz;
}

__device__ __forceinline__ void phase_prologue(PR p, unsigned char* smem) {
  const int tid = otid();
  float* fs = (float*)smem;
  {
    const int j = tid & 255, qh = tid >> 8;
    const float omega = exp2f(-(float)j * (13.287712379549449f / 256.0f));
    for (int r0 = blockIdx.x; r0 < NROW; r0 += 4 * gridDim.x) {
      float va[4], vb[4];
#pragma unroll
      for (int u = 0; u < 4; ++u) {
        const int r = min(r0 + u * (int)gridDim.x, NROW - 1);
        const float* src = (r < NLAT) ? p.x + (size_t)r * DM : p.ctx + (size_t)(r - NLAT) * DM;
        va[u] = __builtin_nontemporal_load(src + tid);
        vb[u] = __builtin_nontemporal_load(src + 512 + tid);
      }
#pragma unroll
      for (int u = 0; u < 4; ++u) {
        const int r = r0 + u * (int)gridDim.x;
        if (r < NROW) {
          float a = va[u], b = vb[u];
          if (r < NLAT) {
            const int t = r & (SEQL - 1);
            const float a0 = (float)(t >> 6) * omega, a1 = (float)(t & 63) * omega;
            a += qh ? __cosf(a0) : __sinf(a0);
            b += qh ? __cosf(a1) : __sinf(a1);
          }
          p.X[(size_t)r * DM + tid] = f2bf(a);
          p.X[(size_t)r * DM + 512 + tid] = f2bf(b);
        }
      }
    }
  }
  for (int it = blockIdx.x; it < 192; it += gridDim.x) {
    const int l = it / 96, n0 = (it % 96) * 64;
    __syncthreads();
    for (int e = tid; e < 3 * DM; e += NTH) {
      const int j = e >> 10, k = e & 1023;
      const float cv = (j < 2) ? p.c[j * DM + k] : p.c_ctx[k];
      fs[e] = siluf_(cv);
    }
    __syncthreads();
    const int n4 = tid & 15, ks = tid >> 4;
    float4 a0 = make_float4(0.f, 0.f, 0.f, 0.f), a1 = a0, a2 = a0;
    const float* W = p.ada_w + (size_t)l * DM * 6144 + n0 + n4 * 4;
#pragma unroll 8
    for (int k = ks * 32; k < ks * 32 + 32; ++k) {
      const f32x4 wv_ = __builtin_nontemporal_load((const f32x4*)(W + (size_t)k * 6144));
      const float4 wv = make_float4(wv_[0], wv_[1], wv_[2], wv_[3]);
      const float c0 = fs[k], c1 = fs[1024 + k], c2 = fs[2048 + k];
      a0.x += c0 * wv.x; a0.y += c0 * wv.y; a0.z += c0 * wv.z; a0.w += c0 * wv.w;
      a1.x += c1 * wv.x; a1.y += c1 * wv.y; a1.z += c1 * wv.z; a1.w += c1 * wv.w;
      a2.x += c2 * wv.x; a2.y += c2 * wv.y; a2.z += c2 * wv.z; a2.w += c2 * wv.w;
    }
    float* red = fs + 3 * DM;
    *(float4*)(red + (ks * 3 + 0) * 64 + n4 * 4) = a0;
    *(float4*)(red + (ks * 3 + 1) * 64 + n4 * 4) = a1;
    *(float4*)(red + (ks * 3 + 2) * 64 + n4 * 4) = a2;
    __syncthreads();
    if (tid < 192) {
      const int j = tid >> 6, nn = tid & 63;
      float s = p.ada_b[l * 6144 + n0 + nn];
#pragma unroll
      for (int q = 0; q < 32; ++q) s += red[(q * 3 + j) * 64 + nn];
      p.MOD[(l * 3 + j) * 6144 + n0 + nn] = s;
    }
  }
  if (blockIdx.x == 0) {
    if (tid < 256) {
      const float a = p.hg_lb_logits[tid], b = p.hg_lb_logits[256 + tid];
      const float m = fmaxf(a, b);
      const float ea = expf(a - m), eb = expf(b - m);
      p.LBv[tid] = 0.f;
      p.LBv[256 + tid] = eb / (ea + eb);
    }
    p.CNT[tid] = 0;
    if (tid < 8) p.WQ[tid] = 0;
  }
  {
    const int lane = tid & 63, w = tid >> 6;
    float* zs = fs;
    const int rot = ((int)blockIdx.x + (int)gridDim.x - (192 % (int)gridDim.x)) % (int)gridDim.x;
    for (int pass = 0; pass < 2; ++pass)
    for (int it = pass ? 256 + rot : (int)blockIdx.x; it < (pass ? 272 : 256); it += gridDim.x) {
      const bool isc = it >= 256;
      const int l = isc ? 0 : it >> 7;
      const int nlg = isc ? 1 : 4;
      const int lag0 = isc ? (it - 256) * 16 : (it & 127) * 64;
      const int L = isc ? 256 : 8192;
      __syncthreads();
      for (int q = 0; q < 2 * nlg; ++q) {
        const int i = lag0 + w * 2 * nlg + q;
        const float tt = (float)i / (float)(L - 1);
        const float wv = 6.283185307179586f * (float)i / (float)L;
        float feat = 0.f;
        if (lane == 0) feat = tt;
        else if (lane < 33) {
          const int jb = (lane - 1) & 15;
          const float band = 1e-4f + (float)jb * ((15.0f - 1e-4f) / 15.0f);
          const float ang = band * wv;
          feat = (lane <= 16) ? cosf(ang) : -sinf(ang);
        }
        float a = p.hy_b1[l * 64 + lane];
        for (int j = 0; j < 33; ++j) a += shu(feat, j) * p.hy_w1[(l * 33 + j) * 64 + lane];
        const float z1 = sinf(p.hy_freq[(l * 2 + 0) * 64 + lane] * a);
        float a2 = p.hy_b2[l * 64 + lane];
        for (int j = 0; j < 64; ++j) a2 += shu(z1, j) * p.hy_w2[(l * 64 + j) * 64 + lane];
        zs[(w * 2 * nlg + q) * 65 + lane] = sinf(p.hy_freq[(l * 2 + 1) * 64 + lane] * a2);
      }
      __syncthreads();
      const float* w3 = p.hy_w3 + (size_t)l * 64 * 1024;
      const int fr = lane & 15, fk = lane >> 4;
#pragma unroll 1
      for (int nh = 0; nh < 2; ++nh) {
        f32x4 c00 = {0.f, 0.f, 0.f, 0.f}, c01 = c00, c02 = c00, c03 = c00, c10 = c00, c11 = c00, c12 = c00, c13 = c00,
              c20 = c00, c21 = c00, c22 = c00, c23 = c00, c30 = c00, c31 = c00, c32 = c00, c33 = c00;
        const float* wb = w3 + (size_t)fk * 1024 + w * 128 + nh * 64 + fr;
        const float* za = zs + fr * 65 + fk;
#pragma unroll 4
        for (int ks = 0; ks < 16; ++ks) {
          const float b0 = wb[(size_t)ks * 4096], b1 = wb[(size_t)ks * 4096 + 16], b2 = wb[(size_t)ks * 4096 + 32], b3 = wb[(size_t)ks * 4096 + 48];
          const float a0 = za[ks * 4], a1 = za[16 * 65 + ks * 4], a2 = za[32 * 65 + ks * 4], a3 = za[48 * 65 + ks * 4];
#define HF_MMA(C, A_, B_) C = __builtin_amdgcn_mfma_f32_16x16x4f32(A_, B_, C, 0, 0, 0)
          HF_MMA(c00, a0, b0); HF_MMA(c01, a0, b1); HF_MMA(c02, a0, b2); HF_MMA(c03, a0, b3);
          HF_MMA(c10, a1, b0); HF_MMA(c11, a1, b1); HF_MMA(c12, a1, b2); HF_MMA(c13, a1, b3);
          HF_MMA(c20, a2, b0); HF_MMA(c21, a2, b1); HF_MMA(c22, a2, b2); HF_MMA(c23, a2, b3);
          HF_MMA(c30, a3, b0); HF_MMA(c31, a3, b1); HF_MMA(c32, a3, b2); HF_MMA(c33, a3, b3);
#undef HF_MMA
        }
#define HF_ST(C, LB, NB) if ((LB) < nlg) { const int n_ = w * 128 + nh * 64 + (NB) * 16 + fr; const int lg_ = lag0 + (LB) * 16 + fk * 4; \
          float* o_ = isc ? p.HFTC + (size_t)n_ * 256 + lg_ : p.HFT + ((size_t)l * 1024 + n_) * 8192 + lg_; \
          *(float4*)o_ = make_float4(C[0], C[1], C[2], C[3]); }
        HF_ST(c00, 0, 0) HF_ST(c01, 0, 1) HF_ST(c02, 0, 2) HF_ST(c03, 0, 3)
        HF_ST(c10, 1, 0) HF_ST(c11, 1, 1) HF_ST(c12, 1, 2) HF_ST(c13, 1, 3)
        HF_ST(c20, 2, 0) HF_ST(c21, 2, 1) HF_ST(c22, 2, 2) HF_ST(c23, 2, 3)
        HF_ST(c30, 3, 0) HF_ST(c31, 3, 1) HF_ST(c32, 3, 2) HF_ST(c33, 3, 3)
#undef HF_ST
      }
    }
  }
  {
    const int gt = blockIdx.x * NTH + tid, ntot = gridDim.x * NTH;
    const int n0c = 2 * 4096 * 128, n1c = 2 * 1024 * 128, n2c = 2 * 512 * 128, n3c = 2 * 1024 * 32, n4c = 2 * 256 * 384;
    for (int e = gt; e < n0c + n1c + n2c + n3c + n4c; e += ntot) {
      const float* src; u16* dst; int n, kc, K, lds_, col; int lo = 0; int kcs;
      bool zero = false;
      if (e < n0c) { const int l = e / (4096 * 128), q = e % (4096 * 128); n = q % 4096; kc = q / 4096; K = 1024; lds_ = DIN; col = (n < DIN) ? n : 0; zero = n >= DIN;
        src = p.w_in + (size_t)l * DM * DIN; dst = p.WinT + (size_t)l * 4096 * 1024; }
      else if (e < n0c + n1c) { const int q0 = e - n0c; const int l = q0 / (1024 * 128), q = q0 % (1024 * 128); n = q % 1024; kc = q / 1024; K = 1024; lds_ = DM; col = n;
        src = p.w_out + (size_t)l * DM * DM; dst = p.WoutT + (size_t)l * 1024 * 1024; }
      else if (e < n0c + n1c + n2c) { const int q0 = e - n0c - n1c; const int l = q0 / (512 * 128), q = q0 % (512 * 128); n = q % 512; kc = q / 512; K = 1024; lds_ = 512;
        col = ((n & 31) < 16) ? ((n >> 5) * 16 + (n & 15)) : (256 + (n >> 5) * 16 + (n & 15));
        src = p.sh_w_gu + (size_t)l * DM * 512; dst = p.ShGuT + (size_t)l * 512 * 1024; }
      else if (e < n0c + n1c + n2c + n3c) { const int q0 = e - n0c - n1c - n2c; const int l = q0 / (1024 * 32), q = q0 % (1024 * 32); n = q % 1024; kc = q / 1024; K = 256; lds_ = DM; col = n;
        src = p.sh_w_down + (size_t)l * 256 * DM; dst = p.ShDnT + (size_t)l * 1024 * 256; }
      else { const int q0 = e - n0c - n1c - n2c - n3c; const int l = q0 / (256 * 384), q = q0 % (256 * 384); n = q % 256; kc = q / 256; K = 3072; lds_ = 256; col = n;
        lo = (kc >= 128 && kc < 256) ? 1 : 0;
        src = p.router_w + (size_t)l * DM * 256; dst = p.RWT + (size_t)l * 256 * 3072; }
      kcs = (K == 3072) ? (kc & 127) : kc;
      const float* sp = src + (size_t)(kcs * 8) * lds_ + col;
#define NTF(P_) __builtin_nontemporal_load(P_)
      float f0 = NTF(sp), f1 = NTF(sp + (size_t)lds_), f2 = NTF(sp + (size_t)2 * lds_), f3 = NTF(sp + (size_t)3 * lds_);
      float f4 = NTF(sp + (size_t)4 * lds_), f5 = NTF(sp + (size_t)5 * lds_), f6 = NTF(sp + (size_t)6 * lds_), f7 = NTF(sp + (size_t)7 * lds_);
#undef NTF
      if (lo) {
        f0 -= bf2f(f2bf(f0)); f1 -= bf2f(f2bf(f1)); f2 -= bf2f(f2bf(f2)); f3 -= bf2f(f2bf(f3));
        f4 -= bf2f(f2bf(f4)); f5 -= bf2f(f2bf(f5)); f6 -= bf2f(f2bf(f6)); f7 -= bf2f(f2bf(f7));
      }
      uint4 o;
      o.x = pk2bf(f0, f1);
      o.y = pk2bf(f2, f3);
      o.z = pk2bf(f4, f5);
      o.w = pk2bf(f6, f7);
      if (zero) o = make_uint4(0u, 0u, 0u, 0u);
      *(uint4*)(dst + (size_t)n * K + kc * 8) = o;
    }
  }
}

__device__ __forceinline__ float4 ldx4(const u16* q) {
  const uint2 t = *(const uint2*)q;
  return make_float4(bf2f((u16)(t.x & 0xFFFF)), bf2f((u16)(t.x >> 16)), bf2f((u16)(t.y & 0xFFFF)), bf2f((u16)(t.y >> 16)));
}
__device__ __forceinline__ void stx4(u16* q, const float4& v) { *(uint2*)q = make_uint2(pk2bf(v.x, v.y), pk2bf(v.z, v.w)); }
__device__ __forceinline__ int mod_index(int r) { return r < NLAT ? (r >> 13) : 2; }

__device__ __forceinline__ void phase_norm1(PR p, int l) {
  const int tid_ = otid();
  const int lane = tid_ & 63;
  const int gw = blockIdx.x * 8 + (tid_ >> 6), nw = gridDim.x * 8;
  const float* g = p.norm_g + (l * 4 + 0) * DM;
  for (int r = gw; r < NROW; r += nw) {
    const float* mod = p.MOD + (l * 3 + mod_index(r)) * 6144;
    float4 xv[4];
    float ss = 0.f;
#pragma unroll
    for (int q = 0; q < 4; ++q) {
      xv[q] = ldx4(p.X + (size_t)r * DM + q * 256 + lane * 4);
      ss += xv[q].x * xv[q].x + xv[q].y * xv[q].y + xv[q].z * xv[q].z + xv[q].w * xv[q].w;
    }
    ss = wave_sum(ss);
    const float rs = rsqrtf(ss * (1.f / DM) + EPSV);
#pragma unroll
    for (int q = 0; q < 4; ++q) {
      const int e = q * 256 + lane * 4;
      const float4 gv = *(const float4*)(g + e);
      const float4 sh = *(const float4*)(mod + e);
      const float4 sc = *(const float4*)(mod + 1024 + e);
      uint2 o;
      o.x = (uint32_t)f2bf(xv[q].x * rs * gv.x * (1.f + sc.x) + sh.x) | ((uint32_t)f2bf(xv[q].y * rs * gv.y * (1.f + sc.y) + sh.y) << 16);
      o.y = (uint32_t)f2bf(xv[q].z * rs * gv.z * (1.f + sc.z) + sh.z) | ((uint32_t)f2bf(xv[q].w * rs * gv.w * (1.f + sc.w) + sh.w) << 16);
      *(uint2*)(p.HN + (size_t)r * DM + e) = o;
    }
  }
}

__device__ __forceinline__ void phase_inproj(PR p, int l, unsigned char* smem) {
  const int NFULL = 66 * 15, NTAIL = 66;
  u16* P_ = p.P; u16* PT_ = p.PT;
  const u16* Wt = p.WinT + (size_t)l * 4096 * 1024;
  TileIter ti;
  for (int it = ti.next(NFULL + NTAIL); it >= 0; it = ti.next(NFULL + NTAIL)) {
    if (it < NFULL) {
      int pm, pn;
      g8_tile(it, 66, 15, pm, pn);
      if (pn < 3)
        gemm256<false, false, 0>(p.HN, p.HN, 1 << 30, DM, Wt, DM, pm * 256, pn * 256, smem,
                       [&](int row0, int col, const f32x4& v, const f32x4&) {
                         *(uint2*)(PT_ + (size_t)col * NROW + row0) = make_uint2(pk2bf(v[0], v[1]), pk2bf(v[2], v[3]));
                       });
      else
        gemm256<false, false, 1>(p.HN, p.HN, 1 << 30, DM, Wt, DM, pm * 256, pn * 256, smem,
                       [&](int row, int col, const float4& v, const float4&) { *(uint2*)(P_ + (size_t)row * DIN + col) = make_uint2(pk2bf(v.x, v.y), pk2bf(v.z, v.w)); });
    } else {
      const int pm = it - NFULL;
      gemm256<false, false, 1>(p.HN, p.HN, 1 << 30, DM, Wt, DM, pm * 256, 3840, smem,
                     [&](int row, int col, const float4& v, const float4&) { if (col < DIN) *(uint2*)(P_ + (size_t)row * DIN + col) = make_uint2(pk2bf(v.x, v.y), pk2bf(v.z, v.w)); },
                     nullptr, 256, 48);
    }
  }
}

__device__ __forceinline__ int lat_row(int b, int t) { return b * SEQL + t; }
__device__ __forceinline__ int ctx_row(int b, int t) { return NLAT + b * CTXL + t; }

__device__ __forceinline__ float hy_sconv(PR p, int l, int rowbase, int t, int L, int ch) {
  const float* cw = p.hy_conv_w + (size_t)l * 3 * 768;
  float a = p.hy_conv_b[l * 768 + ch];
  const u16* Pc = p.PT + (size_t)ch * NROW + rowbase + t;
  if (t > 0) a += bf2f(Pc[-1]) * cw[ch];
  a += bf2f(Pc[0]) * cw[768 + ch];
  if (t < L - 1) a += bf2f(Pc[1]) * cw[2 * 768 + ch];
  return a;
}

#define HY_MIN_DECAY (-3.0701134573253944f)
#define HY_MAX_DECAY (-15.350567286626972f)

__device__ __forceinline__ float2 cmul(float2 a, float2 b) { return make_float2(a.x * b.x - a.y * b.y, a.x * b.y + a.y * b.x); }
__device__ __forceinline__ float2 cmulc(float2 a, float2 b) { return make_float2(a.x * b.x + a.y * b.y, a.y * b.x - a.x * b.y); }

template <bool INV, int S>
__device__ __forceinline__ void fft16k_stage(float2* X, const float2* twh, const float2* twl, int tid) {
  constexpr int Lq = 4096 >> (2 * S);
  constexpr int tsh = 2 * S;
#pragma unroll
  for (int g = 0; g < 4; ++g) {
    float2 a0[2], a1[2], a2[2], a3[2], w1[2];
#pragma unroll
    for (int u = 0; u < 2; ++u) {
      const int bidx = tid + NTH * (g * 2 + u);
      const int j = bidx & (Lq - 1);
      const float2* ptr = X + ((bidx - j) << 2) + j;
      a0[u] = ptr[0]; a1[u] = ptr[Lq]; a2[u] = ptr[2 * Lq]; a3[u] = ptr[3 * Lq];
      const int e1 = j << tsh;
      w1[u] = cmul(twh[e1 >> 7], twl[e1 & 127]);
    }
#pragma unroll
    for (int u = 0; u < 2; ++u) {
      const int bidx = tid + NTH * (g * 2 + u);
      const int j = bidx & (Lq - 1);
      float2* ptr = X + ((bidx - j) << 2) + j;
      const float2 w2 = cmul(w1[u], w1[u]), w3 = cmul(w2, w1[u]);
      if (!INV) {
        const float2 b0 = make_float2(a0[u].x + a2[u].x, a0[u].y + a2[u].y), b1 = make_float2(a0[u].x - a2[u].x, a0[u].y - a2[u].y);
        const float2 b2 = make_float2(a1[u].x + a3[u].x, a1[u].y + a3[u].y), d = make_float2(a1[u].x - a3[u].x, a1[u].y - a3[u].y);
        const float2 b3 = make_float2(d.y, -d.x);
        ptr[0] = make_float2(b0.x + b2.x, b0.y + b2.y);
        ptr[Lq] = cmul(make_float2(b1.x + b3.x, b1.y + b3.y), w1[u]);
        ptr[2 * Lq] = cmul(make_float2(b0.x - b2.x, b0.y - b2.y), w2);
        ptr[3 * Lq] = cmul(make_float2(b1.x - b3.x, b1.y - b3.y), w3);
      } else {
        const float2 y0 = a0[u], y1 = cmulc(a1[u], w1[u]), y2 = cmulc(a2[u], w2), y3 = cmulc(a3[u], w3);
        const float2 b0 = make_float2(y0.x + y2.x, y0.y + y2.y), b1 = make_float2(y0.x - y2.x, y0.y - y2.y);
        const float2 b2 = make_float2(y1.x + y3.x, y1.y + y3.y), d = make_float2(y1.x - y3.x, y1.y - y3.y);
        const float2 b3 = make_float2(-d.y, d.x);
        ptr[0] = make_float2(b0.x + b2.x, b0.y + b2.y);
        ptr[Lq] = make_float2(b1.x + b3.x, b1.y + b3.y);
        ptr[2 * Lq] = make_float2(b0.x - b2.x, b0.y - b2.y);
        ptr[3 * Lq] = make_float2(b1.x - b3.x, b1.y - b3.y);
      }
    }
  }
  __syncthreads();
}
template <bool INV>
__device__ __forceinline__ void fft16k(float2* X, const float2* twh, const float2* twl, int tid) {
  if (!INV) {
    fft16k_stage<false, 0>(X, twh, twl, tid); fft16k_stage<false, 1>(X, twh, twl, tid); fft16k_stage<false, 2>(X, twh, twl, tid);
    fft16k_stage<false, 3>(X, twh, twl, tid); fft16k_stage<false, 4>(X, twh, twl, tid); fft16k_stage<false, 5>(X, twh, twl, tid);
    fft16k_stage<false, 6>(X, twh, twl, tid);
  } else {
    fft16k_stage<true, 6>(X, twh, twl, tid); fft16k_stage<true, 5>(X, twh, twl, tid); fft16k_stage<true, 4>(X, twh, twl, tid);
    fft16k_stage<true, 3>(X, twh, twl, tid); fft16k_stage<true, 2>(X, twh, twl, tid); fft16k_stage<true, 1>(X, twh, twl, tid);
    fft16k_stage<true, 0>(X, twh, twl, tid);
  }
}

__device__ void hyena_latent(PR p, int l, int c, unsigned char* smem) {
  float2* X = (float2*)smem;
  float2* twh = X + 16384;
  float2* twl = twh + 128;
  float* red = (float*)(twl + 128);
  const int tid = otid();
  float zf = 0.f;
  asm volatile("" : "+v"(zf));
  const float delta = fabsf(HY_MIN_DECAY + (float)c * ((HY_MAX_DECAY - HY_MIN_DECAY) / 255.0f));
  __syncthreads();
  if (tid < 128) {
    float sn, cs;
    sincospif((float)tid / 64.0f, &sn, &cs);
    twh[tid] = make_float2(cs, -sn);
  } else if (tid < 256) {
    float sn, cs;
    sincospif((float)(tid - 128) / 8192.0f, &sn, &cs);
    twl[tid - 128] = make_float2(cs, -sn);
  }
  f32x16v g0, g1, g2, g3;
  {
    const float* hf0p = p.HFT + ((size_t)l * 1024 + 0 * 256 + c) * 8192 + tid;
    const float* hb0p = p.HFT + ((size_t)l * 1024 + 1 * 256 + c) * 8192 + tid;
    const float* hf1p = p.HFT + ((size_t)l * 1024 + 2 * 256 + c) * 8192 + tid;
    const float* hb1p = p.HFT + ((size_t)l * 1024 + 3 * 256 + c) * 8192 + tid;
#pragma unroll
    for (int k = 0; k < 16; ++k) {
      g0[k] = __builtin_nontemporal_load(hf0p + NTH * k); g1[k] = __builtin_nontemporal_load(hb0p + NTH * k);
      g2[k] = __builtin_nontemporal_load(hf1p + NTH * k); g3[k] = __builtin_nontemporal_load(hb1p + NTH * k);
    }
  }
  f32x16v ua, ub, xa, xb;
#pragma unroll
  for (int i = 0; i < 16; ++i) {
    const int t = tid + NTH * i;
    ua[i] = hy_sconv(p, l, 0, t, SEQL, c); ub[i] = hy_sconv(p, l, SEQL, t, SEQL, c);
    xa[i] = hy_sconv(p, l, 0, t, SEQL, 256 + c); xb[i] = hy_sconv(p, l, SEQL, t, SEQL, 256 + c);
  }
  {
    __syncthreads();
    float l1a = 0.f, l1b = 0.f;
#pragma unroll
    for (int k = 0; k < 16; ++k) {
      const int i = tid + NTH * k;
      const float win = expf(-((float)i / 8191.0f) * delta);
      const float hf0 = g0[k] * win, hb0 = g1[k] * win, hf1 = g2[k] * win, hb1 = g3[k] * win;
      X[i] = make_float2(hf0, hf1);
      l1a += fabsf(hf0); l1b += fabsf(hf1);
      if (i >= 1) { X[16384 - i] = make_float2(hb0, hb1); l1a += fabsf(hb0); l1b += fabsf(hb1); }
    }
    if (tid == 0) X[8192] = make_float2(zf, zf);
    {
      l1a = wave_sum(l1a); l1b = wave_sum(l1b);
      __syncthreads();
      if ((tid & 63) == 0) { red[tid >> 6] = l1a; red[8 + (tid >> 6)] = l1b; }
      __syncthreads();
      float sa = 0.f, sb = 0.f;
#pragma unroll
      for (int i = 0; i < 8; ++i) { sa += red[i]; sb += red[8 + i]; }
      l1a = sa; l1b = sb;
    }
    const float scl0 = 0.5f / (l1a * 16384.0f), scl1 = 0.5f / (l1b * 16384.0f);
    fft16k<false>(X, twh, twl, tid);
    uint32_t* hs0 = p.HS + ((size_t)c * 2 + 0) * 16384;
    uint32_t* hs1 = p.HS + ((size_t)c * 2 + 1) * 16384;
#pragma unroll 4
    for (int idx = tid; idx < 16384; idx += NTH) {
      unsigned v = __brev((unsigned)idx) >> 18;
      v = ((v & 0x1555u) << 1) | ((v >> 1) & 0x1555u);
      const unsigned kq = (16384u - v) & 16383u;
      unsigned w_ = __brev(kq) >> 18;
      w_ = ((w_ & 0x1555u) << 1) | ((w_ >> 1) & 0x1555u);
      const float2 a_ = X[idx], b_ = X[w_];
      hs0[idx] = pk2bf((a_.x + b_.x) * scl0, (a_.y - b_.y) * scl0);
      hs1[idx] = pk2bf((a_.y + b_.y) * scl1, (b_.x - a_.x) * scl1);
    }
  }
  __syncthreads();
#pragma unroll
  for (int i = 0; i < 16; ++i) {
    const int t = tid + NTH * i;
    X[t] = make_float2(ua[i], ub[i]);
    X[8192 + t] = make_float2(zf, zf);
  }
  __syncthreads();
  u32x16v hq0a, hq0b;
  {
    const uint32_t* hs = p.HS + ((size_t)c * 2 + 0) * 16384 + tid;
#pragma unroll
    for (int i = 0; i < 16; ++i) { hq0a[i] = __builtin_nontemporal_load(hs + NTH * i); hq0b[i] = __builtin_nontemporal_load(hs + NTH * (16 + i)); }
  }
  fft16k<false>(X, twh, twl, tid);
#pragma unroll
  for (int i = 0; i < 16; ++i) {
    const int ia = tid + NTH * i, ib = tid + NTH * (16 + i);
    X[ia] = cmul(X[ia], make_float2(bf2f((u16)(hq0a[i] & 0xFFFF)), bf2f((u16)(hq0a[i] >> 16))));
    X[ib] = cmul(X[ib], make_float2(bf2f((u16)(hq0b[i] & 0xFFFF)), bf2f((u16)(hq0b[i] >> 16))));
  }
  __syncthreads();
  fft16k<true>(X, twh, twl, tid);
  {
    const float bias0 = p.hy_bias[(l * 2 + 0) * 256 + c];
#pragma unroll
    for (int i = 0; i < 16; ++i) {
      const int t = tid + NTH * i;
      const float2 y = X[t];
      const float z0 = xa[i] * (y.x + ua[i] * bias0);
      const float z1 = xb[i] * (y.y + ub[i] * bias0);
      ua[i] = z0; ub[i] = z1;
      X[t] = make_float2(z0, z1);
      X[8192 + t] = make_float2(zf, zf);
    }
#pragma unroll
    for (int i = 0; i < 16; ++i) {
      const int t = tid + NTH * i;
      xa[i] = hy_sconv(p, l, 0, t, SEQL, 512 + c); xb[i] = hy_sconv(p, l, SEQL, t, SEQL, 512 + c);
    }
  }
  __syncthreads();
  u32x16v hq1a, hq1b;
  {
    const uint32_t* hs = p.HS + ((size_t)c * 2 + 1) * 16384 + tid;
#pragma unroll
    for (int i = 0; i < 16; ++i) { hq1a[i] = __builtin_nontemporal_load(hs + NTH * i); hq1b[i] = __builtin_nontemporal_load(hs + NTH * (16 + i)); }
  }
  fft16k<false>(X, twh, twl, tid);
#pragma unroll
  for (int i = 0; i < 16; ++i) {
    const int ia = tid + NTH * i, ib = tid + NTH * (16 + i);
    X[ia] = cmul(X[ia], make_float2(bf2f((u16)(hq1a[i] & 0xFFFF)), bf2f((u16)(hq1a[i] >> 16))));
    X[ib] = cmul(X[ib], make_float2(bf2f((u16)(hq1b[i] & 0xFFFF)), bf2f((u16)(hq1b[i] >> 16))));
  }
  __syncthreads();
  fft16k<true>(X, twh, twl, tid);
  {
    const float bias1 = p.hy_bias[(l * 2 + 1) * 256 + c];
#pragma unroll
    for (int i = 0; i < 16; ++i) {
      const int t = tid + NTH * i;
      const float2 y = X[t];
      p.HYRAW[(size_t)c * NROW + lat_row(0, t)] = xa[i] * (y.x + ua[i] * bias1);
      p.HYRAW[(size_t)c * NROW + lat_row(1, t)] = xb[i] * (y.y + ub[i] * bias1);
    }
  }
  __syncthreads();
}

__device__ void hyena_ctx(PR p, int l, int c, unsigned char* smem) {
  float* G = (float*)smem;
  float* U = G + 512;
  float* red = U + 512;
  const int tid = otid();
  const float delta = fabsf(HY_MIN_DECAY + (float)c * ((HY_MAX_DECAY - HY_MIN_DECAY) / 255.0f));
  const int b = tid >> 8, t = tid & 255;
  float zr = 0.f;
  for (int order = 0; order < 2; ++order) {
    __syncthreads();
    float l1 = 0.f;
    if (tid < 256) {
      const int i = tid;
      const float win = expf(-((float)i / 255.0f) * delta);
      const float hf = p.HFTC[(size_t)((order * 2 + 0) * 256 + c) * 256 + i] * win;
      const float hb = p.HFTC[(size_t)((order * 2 + 1) * 256 + c) * 256 + i] * win;
      G[256 + i] = hf;
      l1 += fabsf(hf);
      if (i >= 1) { G[256 - i] = hb; l1 += fabsf(hb); }
      if (i == 0) G[0] = 0.f;
    }
    if (order == 0) U[tid] = hy_sconv(p, l, NLAT + b * CTXL, t, CTXL, c);
    else U[tid] = zr;
    l1 = block_sum(l1, red);
    const float inv_l1 = 1.0f / l1;
    float acc = 0.f;
#pragma unroll 4
    for (int s2 = 0; s2 < 256; ++s2) acc += G[256 + t - s2] * U[b * 256 + s2];
    const float y = acc * inv_l1 + U[tid] * p.hy_bias[(l * 2 + order) * 256 + c];
    if (order == 0) zr = hy_sconv(p, l, NLAT + b * CTXL, t, CTXL, 256 + c) * y;
    else p.HYRAW[(size_t)c * NROW + ctx_row(b, t)] = hy_sconv(p, l, NLAT + b * CTXL, t, CTXL, 512 + c) * y;
  }
  __syncthreads();
}

struct MixLds {
  u16 Qt[64 * 72];
  u16 Qi[64 * 72];
  u16 Ki[160 * 72];
  u16 KT[64 * 72];
  u16 VT[64 * 72];
  u16 AT[64 * 72];
  u16 ST[64 * 72];
  float osum[64 * 64];
  float wt[8 * 64];
  float dnp[8 * 64];
  float nv[64];
  float den[64];
};
template <int MIX> struct MixCfg;
template <> struct MixCfg<0> { static constexpr int DK = 64; static constexpr bool HASN = false; };
template <> struct MixCfg<1> { static constexpr int DK = 32; static constexpr bool HASN = false; };
template <> struct MixCfg<2> { static constexpr int DK = 64; static constexpr bool HASN = true; };

__device__ __forceinline__ u16* mix_sb(PR p, int mix) { return mix == 0 ? p.SBHG : (mix == 1 ? p.SBGL : p.SBML); }
__device__ __forceinline__ float* mix_dc(PR p, int mix) { return mix == 0 ? p.DCHG : (mix == 1 ? p.DCGL : p.DCML); }

struct MixRaw { f32x8v v, x0, x1, x2; f32x16v rq, rk; };

template <int MIX, bool NEEDQ>
__device__ __forceinline__ void mix_fetch(PR p, int l, int b, int h, int dir, int cc, int tid, MixRaw& r) {
  constexpr int DK = MixCfg<MIX>::DK;
  const int lane = tid & 63, w = tid >> 6;
  const int seg = cc < 4 ? 0 : 1;
  const int kc = seg ? cc - 4 : cc;
  const int L = seg ? SEQL : CTXL;
  const int rowbase = seg ? b * SEQL : NLAT + b * CTXL;
  if (MIX == 2) {
    const int tfirst = dir ? (L - 1 - (kc * 64 + w * 8)) : (kc * 64 + w * 8);
#pragma unroll
    for (int j = 0; j < 10; ++j) {
      const int tr = dir ? (tfirst + 1 - j) : (tfirst - 1 + j);
      const bool ok = (tr >= 0) && (tr < L);
      const u16* Prr = p.P + (size_t)(rowbase + (ok ? tr : tfirst)) * DIN + 2848 + h * 64 + lane;
      const float a_ = NEEDQ ? bf2f(Prr[0]) : 0.f, b_ = bf2f(Prr[256]);
      r.rq[j] = ok ? a_ : 0.f; r.rk[j] = ok ? b_ : 0.f;
    }
  }
#pragma unroll
  for (int i = 0; i < 8; ++i) {
    const int tau = kc * 64 + w * 8 + i;
    const int t = dir ? (L - 1 - tau) : tau;
    const u16* Pr = p.P + (size_t)(rowbase + t) * DIN;
    if (MIX == 0) {
      r.v[i] = bf2f(Pr[1024 + h * 64 + lane]);
      r.x0[i] = bf2f(Pr[(dir ? 1536 : 1280) + h * 64 + lane]);
      if (NEEDQ) r.x1[i] = bf2f(Pr[768 + h * 64 + lane]);
    } else if (MIX == 1) {
      r.v[i] = bf2f(Pr[2304 + h * 64 + lane]);
      r.x0[i] = bf2f(Pr[2176 + h * 32 + (lane & 31)]);
      if (NEEDQ) r.x1[i] = bf2f(Pr[2048 + h * 32 + (lane & 31)]);
      r.x2[i] = bf2f(Pr[2560 + dir * 16 + (lane & 15)]);
    } else {
      r.v[i] = bf2f(Pr[3360 + h * 64 + lane]);
      r.x0[i] = bf2f(Pr[3616 + (dir ? 8 : 0) + h]);
      r.x1[i] = bf2f(Pr[3616 + (dir ? 12 : 4) + h]);
    }
  }
}

struct MixPar { f32x16v au; float gab, lb, ck0, ck1, ck2, ckb, cq0, cq1, cq2, cqb, igb, fgb; };
template <int MIX, bool NEEDQ>
__device__ __forceinline__ void mix_params(PR p, int l, int h, int dir, int tid, MixPar& mp) {
  const int lane = tid & 63;
  if (MIX == 1) {
    const int d = lane & 31;
#pragma unroll
    for (int q_ = 0; q_ < 16; ++q_) mp.au[q_] = p.gla_a_up[(size_t)(l * 2 + dir) * 16 * 128 + q_ * 128 + h * 32 + d];
    mp.gab = p.gla_a_b[(l * 2 + dir) * 128 + h * 32 + d];
  } else if (MIX == 0) {
    mp.lb = p.LBv[l * 256 + h * 64 + lane];
  } else {
    const int chq = h * 64 + lane, chk = 256 + h * 64 + lane;
    const float* cw = p.ml_conv_w + (size_t)l * 3 * 512;
    mp.ck0 = cw[chk]; mp.ck1 = cw[512 + chk]; mp.ck2 = cw[1024 + chk]; mp.ckb = p.ml_conv_b[l * 512 + chk];
    if (NEEDQ) { mp.cq0 = cw[chq]; mp.cq1 = cw[512 + chq]; mp.cq2 = cw[1024 + chq]; mp.cqb = p.ml_conv_b[l * 512 + chq]; }
    mp.igb = p.ml_gate_b[l * 16 + (dir ? 8 : 0) + h];
    mp.fgb = p.ml_gate_b[l * 16 + (dir ? 12 : 4) + h];
  }
}

template <int MIX, bool NEEDQ, int DIR>
__device__ __forceinline__ void mix_xform(PR p, int l, int h, int tid, const MixRaw& r, const MixPar& mp, MixLds* m, float (&qv)[8], float (&kv)[8],
                                          float (&bv)[8], float (&vv)[8], float& B1, float& B2, float& B3, float& bl) {
  constexpr int DK = MixCfg<MIX>::DK;
  constexpr int dir = DIR;
  const int lane = tid & 63, w = tid >> 6;
#pragma unroll
  for (int i = 0; i < 8; ++i) {
    vv[i] = r.v[i];
    float q = 0.f, k = 0.f, g = 0.f;
    if (MIX == 1) {
      float a = mp.gab;
#pragma unroll
      for (int q_ = 0; q_ < 16; ++q_) a += shu(r.x2[i], q_) * mp.au[q_];
      if (lane < DK) {
        if (NEEDQ) q = r.x1[i] * 0.17677669529663687f;
        k = r.x0[i];
        g = flogsigmoid(a) * (1.f / 16.f);
      }
    } else if (MIX == 0) {
      const float z = r.x0[i];
      const float lb = mp.lb;
      const float ls = flogsigmoid(z);
      k = (1.f - lb) * frcp(1.f + fexp(z));
      g = (lb > 0.f) ? __logf(lb + (1.f - lb) * fexp(ls)) : ls;
      if (NEEDQ) q = fsilu(r.x1[i]);
    } else {
      const float kp = dir ? r.rk[i + 2] : r.rk[i], kn = dir ? r.rk[i] : r.rk[i + 2];
      const float ck = mp.ckb + kp * mp.ck0 + r.rk[i + 1] * mp.ck1 + kn * mp.ck2;
      if (NEEDQ) {
        const float qp = dir ? r.rq[i + 2] : r.rq[i], qn = dir ? r.rq[i] : r.rq[i + 2];
        const float cq = mp.cqb + qp * mp.cq0 + r.rq[i + 1] * mp.cq1 + qn * mp.cq2;
        q = fsilu(cq);
      }
      const float ig = r.x0[i] + mp.igb;
      const float fg = r.x1[i] + mp.fgb;
      k = fsilu(ck) * 0.125f * fexp(ig);
      g = flogsigmoid(fg);
    }
    qv[i] = q; kv[i] = k; bv[i] = g;
  }
  float run = 0.f;
#pragma unroll
  for (int i = 0; i < 8; ++i) { run += bv[i]; bv[i] = run; }
  __syncthreads();
  m->wt[w * 64 + lane] = run;
  __syncthreads();
  float off = 0.f;
  B1 = 0.f; B2 = 0.f; B3 = 0.f; bl = 0.f;
#pragma unroll
  for (int ww = 0; ww < 8; ++ww) {
    const float x = m->wt[ww * 64 + lane];
    if (ww < w) off += x;
    if (ww < 2) B1 += x;
    if (ww < 4) B2 += x;
    if (ww < 6) B3 += x;
    bl += x;
  }
#pragma unroll
  for (int i = 0; i < 8; ++i) bv[i] += off;
}

__device__ __forceinline__ uint4 pack8(const float (&x)[8]) {
  uint4 r;
  r.x = pk2bf(x[0], x[1]);
  r.y = pk2bf(x[2], x[3]);
  r.z = pk2bf(x[4], x[5]);
  r.w = pk2bf(x[6], x[7]);
  return r;
}
__device__ __forceinline__ bf16x8 lds_frag(const u16* base, int row0, int k0, int lane) {
  return *(const bf16x8*)(base + (row0 + (lane & 15)) * 72 + k0 + (lane >> 4) * 8);
}

template <int MIX>
__device__ __forceinline__ void mix_summary(PR p, int l, int chain, int cc, const MixRaw& raw, const MixPar& mp, MixLds* m) {
  constexpr int DK = MixCfg<MIX>::DK;
  const int tid = otid();
  const int lane = tid & 63, w = tid >> 6;
  const int h = (chain >> 1) & 3;
  float qv[8], kv[8], bv[8], vv[8], B1, B2, B3, bl;
  if (chain & 1) mix_xform<MIX, false, 1>(p, l, h, tid, raw, mp, m, qv, kv, bv, vv, B1, B2, B3, bl);
  else mix_xform<MIX, false, 0>(p, l, h, tid, raw, mp, m, qv, kv, bv, vv, B1, B2, B3, bl);
  float ke[8];
  float dn = 0.f;
#pragma unroll
  for (int i = 0; i < 8; ++i) { ke[i] = kv[i] * fexp(bl - bv[i]); dn += ke[i]; }
  if (lane < DK) *(uint4*)(&m->KT[lane * 72 + w * 8]) = pack8(ke);
  *(uint4*)(&m->VT[lane * 72 + w * 8]) = pack8(vv);
  if (MIX == 2) m->dnp[w * 64 + lane] = dn;
  __syncthreads();
  u16* sb = mix_sb(p, MIX) + ((size_t)chain * NCH + cc) * (DK * 64);
  for (int tile = w; tile < (DK / 16) * 4; tile += 8) {
    const int db = tile >> 2, vb = tile & 3;
    f32x4 acc = {0.f, 0.f, 0.f, 0.f};
#pragma unroll
    for (int ks = 0; ks < 2; ++ks)
      acc = __builtin_amdgcn_mfma_f32_16x16x32_bf16(lds_frag(m->KT, db * 16, ks * 32, lane), lds_frag(m->VT, vb * 16, ks * 32, lane), acc, 0, 0, 0);
#pragma unroll
    for (int r = 0; r < 4; ++r) sb[(db * 16 + (lane >> 4) * 4 + r) * 64 + vb * 16 + (lane & 15)] = f2bf(acc[r]);
  }
  if (w == 0 && lane < DK) mix_dc(p, MIX)[((size_t)chain * NCH + cc) * DK + lane] = fexp(bl);
  if (MIX == 2 && w == 1) {
    float s2 = 0.f;
#pragma unroll
    for (int ww = 0; ww < 8; ++ww) s2 += m->dnp[ww * 64 + lane];
    p.NBML[((size_t)chain * NCH + cc) * 64 + lane] = s2;
  }
}

template <int MIX, int DIR>
__device__ __forceinline__ void mix_output_dir(PR p, int l, int b, int h, int tid, const MixRaw& raw, const float (&sv)[8], float nvp, MixLds* m) {
  constexpr int DK = MixCfg<MIX>::DK;
  constexpr bool HASN = MixCfg<MIX>::HASN;
  constexpr int dir = DIR;
  const int lane = tid & 63, w = tid >> 6;
  float qv[8], kv[8], bv[8], vv[8], B1, B2, B3, bl;
  MixPar mp;
  mix_params<MIX, true>(p, l, h, DIR, tid, mp);
  mix_xform<MIX, true, DIR>(p, l, h, tid, raw, mp, m, qv, kv, bv, vv, B1, B2, B3, bl);
  const int J = w >> 1;
  const float BJ = (J == 0) ? 0.f : (J == 1 ? B1 : (J == 2 ? B2 : B3));
  if (lane < DK) {
#pragma unroll
    for (int i = 0; i < 8; ++i) {
      const int tau = w * 8 + i;
      m->Qt[tau * 72 + lane] = f2bf(qv[i] * fexp(bv[i]));
      m->Qi[tau * 72 + lane] = f2bf(qv[i] * fexp(bv[i] - BJ));
      if (J <= 0) m->Ki[(0 + tau) * 72 + lane] = f2bf(kv[i] * fexp(fminf(0.f - bv[i], 80.f)));
      if (J <= 1) m->Ki[(16 + tau) * 72 + lane] = f2bf(kv[i] * fexp(fminf(B1 - bv[i], 80.f)));
      if (J <= 2) m->Ki[(48 + tau) * 72 + lane] = f2bf(kv[i] * fexp(fminf(B2 - bv[i], 80.f)));
      m->Ki[(96 + tau) * 72 + lane] = f2bf(kv[i] * fexp(fminf(B3 - bv[i], 80.f)));
    }
  }
  *(uint4*)(&m->VT[lane * 72 + w * 8]) = pack8(vv);
  {
    constexpr int DPW = DK / 8;
    if (DPW == 8) *(uint4*)(&m->ST[lane * 72 + w * 8]) = pack8(sv);
    else *(uint2*)(&m->ST[lane * 72 + w * 4]) = make_uint2(pk2bf(sv[0], sv[1]), pk2bf(sv[2], sv[3]));
    if (HASN && w == 0) m->nv[lane] = nvp;
  }
  __syncthreads();
#pragma unroll
  for (int q = 0; q < 2; ++q) {
    const int blk = w * 2 + q;
    const int I = blk >> 2, Jb = blk & 3;
    f32x4 acc = {0.f, 0.f, 0.f, 0.f};
    if (Jb <= I) {
      const int kioff = (I == 0) ? 0 : (I == 1 ? 16 : (I == 2 ? 48 : 96));
#pragma unroll
      for (int ks = 0; ks < DK / 32; ++ks)
        acc = __builtin_amdgcn_mfma_f32_16x16x32_bf16(lds_frag(m->Qi, I * 16, ks * 32, lane), lds_frag(m->Ki, kioff + Jb * 16, ks * 32, lane), acc, 0, 0, 0);
    }
#pragma unroll
    for (int r = 0; r < 4; ++r) {
      const int tl_ = (lane >> 4) * 4 + r, sl_ = lane & 15;
      float a = acc[r];
      if (Jb == I && sl_ > tl_) a = 0.f;
      m->AT[(I * 16 + tl_) * 72 + Jb * 16 + sl_] = f2bf(a);
    }
  }
  __syncthreads();
  if (HASN) {
#pragma unroll
    for (int i = 0; i < 8; ++i) {
      const int tau = w * 8 + i;
      float x = bf2f(m->AT[tau * 72 + lane]) + bf2f(m->Qt[tau * 72 + lane]) * m->nv[lane];
      x = wave_sum(x);
      if (lane == 0) m->den[tau] = fmaxf(fabsf(x), 1.0f);
    }
    __syncthreads();
  }
#pragma unroll
  for (int q = 0; q < 2; ++q) {
    const int tile = w * 2 + q;
    const int I = tile >> 2, vb = tile & 3;
    f32x4 acc = {0.f, 0.f, 0.f, 0.f};
#pragma unroll
    for (int ks = 0; ks < DK / 32; ++ks)
      acc = __builtin_amdgcn_mfma_f32_16x16x32_bf16(lds_frag(m->Qt, I * 16, ks * 32, lane), lds_frag(m->ST, vb * 16, ks * 32, lane), acc, 0, 0, 0);
#pragma unroll
    for (int ks = 0; ks < 2; ++ks)
      acc = __builtin_amdgcn_mfma_f32_16x16x32_bf16(lds_frag(m->AT, I * 16, ks * 32, lane), lds_frag(m->VT, vb * 16, ks * 32, lane), acc, 0, 0, 0);
#pragma unroll
    for (int r = 0; r < 4; ++r) {
      const int tau = I * 16 + (lane >> 4) * 4 + r;
      float o = acc[r];
      if (HASN) o *= frcp(m->den[tau]);
      const int slot = dir ? 63 - tau : tau;
      m->osum[slot * 64 + vb * 16 + (lane & 15)] += o;
    }
  }
  __syncthreads();
}

template <int MIX>
__device__ __forceinline__ void mix_output(PR p, int l, int b, int h, int seg, int j, MixLds* m) {
  constexpr int DK = MixCfg<MIX>::DK;
  constexpr int DPW = DK / 8;
  const int tid = otid();
  const int lane = tid & 63, w = tid >> 6;
  const int nseg = seg ? 128 : 4;
  const int cbase = seg ? 4 : 0;
  const int L = seg ? SEQL : CTXL;
  const int rowbase = seg ? b * SEQL : NLAT + b * CTXL;
  const int cc0 = cbase + j, cc1 = cbase + (nseg - 1 - j);
  const int chain0 = (b * 4 + h) * 2, chain1 = chain0 + 1;
  MixRaw r0, r1;
  mix_fetch<MIX, true>(p, l, b, h, 0, cc0, tid, r0);
  mix_fetch<MIX, true>(p, l, b, h, 1, cc1, tid, r1);
  float sv0[8], sv1[8], gate[8];
  {
    const u16* sb0 = mix_sb(p, MIX) + ((size_t)chain0 * NCH + cc0) * (DK * 64);
    const u16* sb1 = mix_sb(p, MIX) + ((size_t)chain1 * NCH + cc1) * (DK * 64);
#pragma unroll
    for (int i = 0; i < 8; ++i) {
      sv0[i] = (i < DPW) ? bf2f(__builtin_nontemporal_load(sb0 + (w * DPW + i) * 64 + lane)) : 0.f;
      sv1[i] = (i < DPW) ? bf2f(__builtin_nontemporal_load(sb1 + (w * DPW + i) * 64 + lane)) : 0.f;
    }
  }
  const float nv0 = (MIX == 2) ? p.NBML[((size_t)chain0 * NCH + cc0) * 64 + lane] : 0.f;
  const float nv1 = (MIX == 2) ? p.NBML[((size_t)chain1 * NCH + cc1) * 64 + lane] : 0.f;
#pragma unroll
  for (int i = 0; i < 8; ++i) {
    const int t = j * 64 + w + 8 * i;
    const u16* Pr = p.P + (size_t)(rowbase + t) * DIN;
    gate[i] = bf2f(__builtin_nontemporal_load(Pr + ((MIX == 0) ? 1792 : (MIX == 1 ? 2592 : 3632)) + h * 64 + lane));
  }
  __syncthreads();
  for (int idx = tid; idx < 4096; idx += NTH) m->osum[idx] = 0.f;
  mix_output_dir<MIX, 0>(p, l, b, h, tid, r0, sv0, nv0, m);
  mix_output_dir<MIX, 1>(p, l, b, h, tid, r1, sv1, nv1, m);
#pragma unroll
  for (int i = 0; i < 8; ++i) {
    const int tk = w + 8 * i;
    const int t = j * 64 + tk;
    const float o = m->osum[tk * 64 + lane];
    const float ms = wave_sum(o * o) * (1.f / 64.f);
    const float on = o * rsqrtf(ms + EPSV);
    float y;
    int col;
    if (MIX == 0) { y = on * p.hg_norm[l * 256 + h * 64 + lane] * fsilu(gate[i]); col = 256 + h * 64 + lane; }
    else if (MIX == 1) { y = on * p.gla_norm[l * 256 + h * 64 + lane] * fsilu(gate[i]); col = 512 + h * 64 + lane; }
    else { y = fsigmoid(gate[i]) * on * p.ml_norm[l * 256 + h * 64 + lane]; col = 768 + h * 64 + lane; }
    p.YMIX[(size_t)(rowbase + t) * DM + col] = f2bf(y);
  }
}

template <int MIX>
__device__ __forceinline__ void mixA_loop(PR p, int l, MixLds* m) {
  const int NQ = 16 * NCH, G = gridDim.x;
  const int tid = otid();
  int q0 = ((int)blockIdx.x + G - (MIX * 85) % G) % G;
  MixRaw ra, rb;
  MixPar pa, pb;
#define MIXA_FETCH(Q, R) { const int qq_ = min((Q), NQ - 1); const int chain_ = qq_ / NCH, cc_ = qq_ % NCH; \
    mix_fetch<MIX, false>(p, l, chain_ >> 3, (chain_ >> 1) & 3, chain_ & 1, cc_, tid, R); }
#define MIXA_PAR(Q, PP) { const int chain_ = min((Q), NQ - 1) / NCH; mix_params<MIX, false>(p, l, (chain_ >> 1) & 3, chain_ & 1, tid, PP); }
#define MIXA_ITEM(Q, R, PP) { const int chain_ = (Q) / NCH, cc_ = (Q) % NCH; mix_summary<MIX>(p, l, chain_, cc_, R, PP, m); }
  MIXA_FETCH(q0, ra)
  for (; q0 < NQ; q0 += 2 * G) {
    const int q1 = q0 + G, q2 = q0 + 2 * G;
    MIXA_PAR(q0, pa)
    MIXA_FETCH(q1, rb)
    MIXA_ITEM(q0, ra, pa)
    MIXA_PAR(q1, pb)
    MIXA_FETCH(q2, ra)
    if (q1 < NQ) MIXA_ITEM(q1, rb, pb)
  }
#undef MIXA_PAR
#undef MIXA_FETCH
#undef MIXA_ITEM
}
__device__ __forceinline__ void phase_mixA(PR p, int l, unsigned char* smem) {
  MixLds* m = (MixLds*)smem;
  const int n_hy = 256 + (l == 0 ? 256 : 0);
  for (int it = blockIdx.x; it < n_hy; it += gridDim.x) {
    if (it < 256) hyena_latent(p, l, it, smem);
    else hyena_ctx(p, l, it - 256, smem);
  }
  mixA_loop<0>(p, l, m);
  mixA_loop<1>(p, l, m);
  mixA_loop<2>(p, l, m);
}

__device__ __forceinline__ float scan_ld(const u16* q) { return bf2f(__builtin_nontemporal_load(q)); }
__device__ __forceinline__ float scan_ld(const float* q) { return __builtin_nontemporal_load(q); }
__device__ __forceinline__ void scan_st(u16* q, float v) { *q = f2bf(v); }
__device__ __forceinline__ void scan_st(float* q, float v) { *q = v; }
template <class T>
__device__ __forceinline__ void scan_chain(T* ptr, const float* dp, int sz, int dk) {
  float s = 0.f;
  float dv0 = scan_ld(ptr + 0 * (size_t)sz), dv1 = scan_ld(ptr + 1 * (size_t)sz), dv2 = scan_ld(ptr + 2 * (size_t)sz), dv3 = scan_ld(ptr + 3 * (size_t)sz);
  float de0 = dp[0 * dk], de1 = dp[1 * dk], de2 = dp[2 * dk], de3 = dp[3 * dk];
  for (int cc = 0; cc < NCH; cc += 4) {
    float nv0 = 0.f, nv1 = 0.f, nv2 = 0.f, nv3 = 0.f, ne0 = 0.f, ne1 = 0.f, ne2 = 0.f, ne3 = 0.f;
    if (cc + 4 < NCH) {
      nv0 = scan_ld(ptr + (size_t)(cc + 4) * sz); nv1 = scan_ld(ptr + (size_t)(cc + 5) * sz);
      nv2 = scan_ld(ptr + (size_t)(cc + 6) * sz); nv3 = scan_ld(ptr + (size_t)(cc + 7) * sz);
      ne0 = dp[(cc + 4) * dk]; ne1 = dp[(cc + 5) * dk]; ne2 = dp[(cc + 6) * dk]; ne3 = dp[(cc + 7) * dk];
    }
    scan_st(ptr + (size_t)(cc + 0) * sz, s); s = de0 * s + dv0;
    scan_st(ptr + (size_t)(cc + 1) * sz, s); s = de1 * s + dv1;
    scan_st(ptr + (size_t)(cc + 2) * sz, s); s = de2 * s + dv2;
    scan_st(ptr + (size_t)(cc + 3) * sz, s); s = de3 * s + dv3;
    dv0 = nv0; dv1 = nv1; dv2 = nv2; dv3 = nv3; de0 = ne0; de1 = ne1; de2 = ne2; de3 = ne3;
  }
}
__device__ __forceinline__ void scan_chain2(u16* ptr, const float* dp, int sz, int dk) {
  float s0 = 0.f, s1 = 0.f;
#define SC_LD(C) __builtin_nontemporal_load((const uint32_t*)(ptr + (size_t)(C) * sz))
#define SC_ST(C) *(uint32_t*)(ptr + (size_t)(C) * sz) = pk2bf(s0, s1)
#define SC_UP(D, V) s0 = (D) * s0 + bf2f((u16)((V) & 0xFFFF)); s1 = (D) * s1 + bf2f((u16)((V) >> 16))
  uint32_t dv0 = SC_LD(0), dv1 = SC_LD(1), dv2 = SC_LD(2), dv3 = SC_LD(3);
  float de0 = dp[0 * dk], de1 = dp[1 * dk], de2 = dp[2 * dk], de3 = dp[3 * dk];
  for (int cc = 0; cc < NCH; cc += 4) {
    uint32_t nv0 = 0, nv1 = 0, nv2 = 0, nv3 = 0;
    float ne0 = 0.f, ne1 = 0.f, ne2 = 0.f, ne3 = 0.f;
    if (cc + 4 < NCH) {
      nv0 = SC_LD(cc + 4); nv1 = SC_LD(cc + 5); nv2 = SC_LD(cc + 6); nv3 = SC_LD(cc + 7);
      ne0 = dp[(cc + 4) * dk]; ne1 = dp[(cc + 5) * dk]; ne2 = dp[(cc + 6) * dk]; ne3 = dp[(cc + 7) * dk];
    }
    SC_ST(cc + 0); SC_UP(de0, dv0);
    SC_ST(cc + 1); SC_UP(de1, dv1);
    SC_ST(cc + 2); SC_UP(de2, dv2);
    SC_ST(cc + 3); SC_UP(de3, dv3);
    dv0 = nv0; dv1 = nv1; dv2 = nv2; dv3 = nv3; de0 = ne0; de1 = ne1; de2 = ne2; de3 = ne3;
  }
#undef SC_LD
#undef SC_ST
#undef SC_UP
}
__device__ __forceinline__ void phase_scan(PR p, int l) {
  const int gt = blockIdx.x * NTH + otid(), ntot = gridDim.x * NTH;
  const int n0 = 16 * 2048, n1 = 16 * 1024, n2 = 16 * 2048, n3 = 16 * 64;
  for (int e = gt; e < n0 + n1 + n2 + n3; e += ntot) {
    if (e < n0 + n1 + n2) {
      u16* sb; const float* dc; int sz, dk, chain, idx;
      if (e < n0) { sb = p.SBHG; dc = p.DCHG; sz = 4096; dk = 64; chain = e / 2048; idx = (e % 2048) * 2; }
      else if (e < n0 + n1) { const int q = e - n0; sb = p.SBGL; dc = p.DCGL; sz = 2048; dk = 32; chain = q / 1024; idx = (q % 1024) * 2; }
      else { const int q = e - n0 - n1; sb = p.SBML; dc = p.DCML; sz = 4096; dk = 64; chain = q / 2048; idx = (q % 2048) * 2; }
      scan_chain2(sb + ((size_t)chain * NCH) * sz + idx, dc + ((size_t)chain * NCH) * dk + (idx >> 6), sz, dk);
    } else {
      const int q = e - n0 - n1 - n2;
      const int chain = q / 64, d = q % 64;
      scan_chain(p.NBML + ((size_t)chain * NCH) * 64 + d, p.DCML + ((size_t)chain * NCH) * 64 + d, 64, 64);
    }
  }
}

__device__ __forceinline__ void phase_mixC(PR p, int l, unsigned char* smem) {
  MixLds* m = (MixLds*)smem;
  const int nchk = (l == 0) ? 132 : 128;
  const int n_mix = 2 * nchk * 12;
  for (int it = blockIdx.x; it < n_mix; it += gridDim.x) {
    const int rg = it / 12, sub = it % 12;
    const int mix = sub >> 2, h = sub & 3;
    const int b = rg / nchk, c = rg % nchk;
    const int seg = c < 128 ? 1 : 0, j = c < 128 ? c : c - 128;
    if (mix == 0) mix_output<0>(p, l, b, h, seg, j, m);
    else if (mix == 1) mix_output<1>(p, l, b, h, seg, j, m);
    else mix_output<2>(p, l, b, h, seg, j, m);
  }
  {
    float* tl = (float*)smem;
    const int tid = otid();
    const int lane = tid & 63, w = tid >> 6;
    const int nrows = (l == 0) ? NROW : NLAT;
    for (int it = blockIdx.x; it < nrows / 64; it += gridDim.x) {
      const int r0 = it * 64;
      __syncthreads();
      {
        float hv[32];
#pragma unroll
        for (int i = 0; i < 32; ++i) hv[i] = __builtin_nontemporal_load(p.HYRAW + (size_t)((tid >> 6) + 8 * i) * NROW + r0 + (tid & 63));
#pragma unroll
        for (int i = 0; i < 32; ++i) tl[((tid >> 6) + 8 * i) * 65 + (tid & 63)] = hv[i];
      }
      __syncthreads();
      for (int rr = w; rr < 64; rr += 8) {
        float v[4];
        float ss = 0.f;
#pragma unroll
        for (int q = 0; q < 4; ++q) { v[q] = tl[(lane * 4 + q) * 65 + rr]; ss += v[q] * v[q]; }
        const float rs = rsqrtf(wave_sum(ss) * (1.f / 256.f) + EPSV);
        const float4 g = *(const float4*)(p.hy_norm + l * 256 + lane * 4);
        uint2 o;
        o.x = (uint32_t)f2bf(v[0] * rs * g.x) | ((uint32_t)f2bf(v[1] * rs * g.y) << 16);
        o.y = (uint32_t)f2bf(v[2] * rs * g.z) | ((uint32_t)f2bf(v[3] * rs * g.w) << 16);
        *(uint2*)(p.YMIX + (size_t)(r0 + rr) * DM + lane * 4) = o;
      }
    }
  }
}

__device__ __forceinline__ void phase_outproj(PR p, int l, unsigned char* smem) {
  const int nM = ((l == 0) ? NROW : NLAT) / 256;
  u16* YO_ = p.YOB;
  TileIter ti;
  for (int it = ti.next(nM * 4); it >= 0; it = ti.next(nM * 4)) {
    int pm, pn;
    g8_tile(it, nM, 4, pm, pn);
    gemm256<false, false, 1>(p.YMIX, p.YMIX, 1 << 30, DM, p.WoutT + (size_t)l * 1024 * 1024, DM, pm * 256, pn * 256, smem,
                   [&](int row, int col, const float4& v, const float4&) {
                     *(uint2*)(YO_ + (size_t)row * DM + col) = make_uint2(pk2bf(v.x, v.y), pk2bf(v.z, v.w));
                   });
  }
}

__device__ __forceinline__ void phase_post1(PR p, int l) {
  const int tid_ = otid();
  const int lane = tid_ & 63;
  const int gw = blockIdx.x * 8 + (tid_ >> 6), nw = gridDim.x * 8;
  const float* ng1 = p.norm_g + (l * 4 + 1) * DM;
  const float* ng2 = p.norm_g + (l * 4 + 2) * DM;
  const int nrows = (l == 0) ? NROW : NLAT;
  for (int r = gw; r < nrows; r += nw) {
    const float* mod = p.MOD + (l * 3 + mod_index(r)) * 6144;
    float4 yv[4], xv[4];
    float ss = 0.f;
#pragma unroll
    for (int q = 0; q < 4; ++q) {
      const u32x2v yb = __builtin_nontemporal_load((const u32x2v*)(p.YOB + (size_t)r * DM + q * 256 + lane * 4));
      yv[q] = make_float4(bf2f((u16)(yb.x & 0xFFFF)), bf2f((u16)(yb.x >> 16)), bf2f((u16)(yb.y & 0xFFFF)), bf2f((u16)(yb.y >> 16)));
      ss += yv[q].x * yv[q].x + yv[q].y * yv[q].y + yv[q].z * yv[q].z + yv[q].w * yv[q].w;
    }
    ss = wave_sum(ss);
    const float rs = rsqrtf(ss * (1.f / DM) + EPSV);
    float s2 = 0.f;
#pragma unroll
    for (int q = 0; q < 4; ++q) {
      const int e = q * 256 + lane * 4;
      const float4 gv = *(const float4*)(ng1 + e);
      const float4 g1 = *(const float4*)(mod + 2048 + e);
      float4 xx = ldx4(p.X + (size_t)r * DM + e);
      xx.x += g1.x * (yv[q].x * rs * gv.x); xx.y += g1.y * (yv[q].y * rs * gv.y);
      xx.z += g1.z * (yv[q].z * rs * gv.z); xx.w += g1.w * (yv[q].w * rs * gv.w);
      xv[q] = xx;
      stx4(p.X + (size_t)r * DM + e, xx);
      s2 += xx.x * xx.x + xx.y * xx.y + xx.z * xx.z + xx.w * xx.w;
    }
    s2 = wave_sum(s2);
    const float rs2 = rsqrtf(s2 * (1.f / DM) + EPSV);
#pragma unroll
    for (int q = 0; q < 4; ++q) {
      const int e = q * 256 + lane * 4;
      const float4 gv = *(const float4*)(ng2 + e);
      const float4 sh = *(const float4*)(mod + 3072 + e);
      const float4 sc = *(const float4*)(mod + 4096 + e);
      float4 hv;
      hv.x = xv[q].x * rs2 * gv.x * (1.f + sc.x) + sh.x; hv.y = xv[q].y * rs2 * gv.y * (1.f + sc.y) + sh.y;
      hv.z = xv[q].z * rs2 * gv.z * (1.f + sc.z) + sh.z; hv.w = xv[q].w * rs2 * gv.w * (1.f + sc.w) + sh.w;
      uint2 o;
      o.x = pk2bf(hv.x, hv.y);
      o.y = pk2bf(hv.z, hv.w);
      *(uint2*)(p.HN + (size_t)r * DM + e) = o;
      uint2 o2;
      o2.x = pk2bf(hv.x - bf2f((u16)(o.x & 0xFFFF)), hv.y - bf2f((u16)(o.x >> 16)));
      o2.y = pk2bf(hv.z - bf2f((u16)(o.y & 0xFFFF)), hv.w - bf2f((u16)(o.y >> 16)));
      *(uint2*)(p.HLO + (size_t)r * DM + e) = o2;
    }
  }
}

__device__ __forceinline__ void convert_experts(PR p, int l, unsigned char* smem) {
  float* T = (float*)smem;
  int* sidx = (int*)(smem + 70000);
  const int tid = otid();
  int nextt = (tid == 0) ? atomicAdd(&p.WQ[l], 4) : 0;
  for (;;) {
    __syncthreads();
    if (tid == 0) *sidx = nextt;
    __syncthreads();
    const int base = __builtin_amdgcn_readfirstlane(*sidx);
    if (base >= 256 * 48) break;
    if (tid == 0) nextt = atomicAdd(&p.WQ[l], 4);
  for (int it = base; it < base + 4; ++it) {
    const int e = it / 48, q = it % 48;
    const float* src; u16* dst; int ldn, K, k0, n0; bool gu;
    if (q < 32) { gu = true; k0 = (q >> 1) * 64; n0 = (q & 1) * 256; ldn = 512; K = 1024;
      src = p.exp_w_gu + ((size_t)l * 256 + e) * DM * 512; dst = p.EGU + (size_t)e * 512 * 1024; }
    else { const int q2 = q - 32; gu = false; k0 = (q2 >> 2) * 64; n0 = (q2 & 3) * 256; ldn = 1024; K = 256;
      src = p.exp_w_down + ((size_t)l * 256 + e) * 256 * DM; dst = p.EDN + (size_t)e * 1024 * 256; }
    const float* sp0 = src + (size_t)(k0 + (tid >> 6)) * ldn + n0 + (tid & 63) * 4;
#define NTL(P_) __builtin_nontemporal_load((const f32x4*)(P_))
    const f32x4 v0 = NTL(sp0), v1 = NTL(sp0 + (size_t)8 * ldn), v2 = NTL(sp0 + (size_t)16 * ldn), v3 = NTL(sp0 + (size_t)24 * ldn),
                v4 = NTL(sp0 + (size_t)32 * ldn), v5 = NTL(sp0 + (size_t)40 * ldn), v6 = NTL(sp0 + (size_t)48 * ldn), v7 = NTL(sp0 + (size_t)56 * ldn);
#undef NTL
    __syncthreads();
    float* tq = T + (tid >> 6) * 260 + (tid & 63) * 4;
    *(f32x4*)(tq) = v0; *(f32x4*)(tq + 8 * 260) = v1; *(f32x4*)(tq + 16 * 260) = v2; *(f32x4*)(tq + 24 * 260) = v3;
    *(f32x4*)(tq + 32 * 260) = v4; *(f32x4*)(tq + 40 * 260) = v5; *(f32x4*)(tq + 48 * 260) = v6; *(f32x4*)(tq + 56 * 260) = v7;
    __syncthreads();
#pragma unroll
    for (int i = 0; i < 4; ++i) {
      const int c = tid + 512 * i;
      const int n = c & 255, kc = c >> 8;
      const float* tp = T + (kc * 8) * 260 + n;
      uint4 o;
      o.x = pk2bf(tp[0], tp[260]); o.y = pk2bf(tp[2 * 260], tp[3 * 260]);
      o.z = pk2bf(tp[4 * 260], tp[5 * 260]); o.w = pk2bf(tp[6 * 260], tp[7 * 260]);
      const int col = n0 + n;
      int orow;
      if (gu) orow = (col < 256) ? ((col >> 4) * 32 + (col & 15)) : (((col - 256) >> 4) * 32 + 16 + (col & 15));
      else orow = col;
      *(uint4*)(dst + (size_t)orow * K + k0 + kc * 8) = o;
    }
  }
  }
}

__device__ __forceinline__ void phase_router(PR p, int l, unsigned char* smem) {
  const int tid = otid();
  const int nrows = (l == 0) ? NROW : NLAT;
  int* cnt = p.CNT + l * 256;
  float* LG = p.YO;
  for (int pm = blockIdx.x; pm < nrows / 256; pm += gridDim.x) {
    gemm256<false, false, 1>(p.HN, p.HLO, 32, DM, p.RWT + (size_t)l * 256 * 3072, 3072, pm * 256, 0, smem,
                   [&](int row, int col, const float4& v, const float4&) { *(float4*)(LG + (size_t)row * 256 + col) = v; });
    __syncthreads();
    {
      const int t2 = otid();
      const int lane = t2 & 63, w = t2 >> 6;
      const float4 rb = *(const float4*)(p.router_b + l * 256 + lane * 4);
      f32x4 lgn = __builtin_nontemporal_load((const f32x4*)(LG + (size_t)(pm * 256 + w) * 256 + lane * 4));
      int prow = 0, pmye = 0, ppos = 0;
      float pwv = 0.f;
      for (int rr = w; rr < 256; rr += 8) {
        const int row = pm * 256 + rr;
        const f32x4 lg_ = lgn;
        lgn = __builtin_nontemporal_load((const f32x4*)(LG + (size_t)(pm * 256 + min(rr + 8, 255)) * 256 + lane * 4));
        const float4 lg = make_float4(lg_[0], lg_[1], lg_[2], lg_[3]);
        const float s0 = sigmoidf_(lg.x), s1 = sigmoidf_(lg.y), s2 = sigmoidf_(lg.z), s3 = sigmoidf_(lg.w);
        float v0 = s0 + rb.x, v1 = s1 + rb.y, v2 = s2 + rb.z, v3 = s3 + rb.w;
        float m1 = fmaxf(fmaxf(v0, v1), fmaxf(v2, v3));
        float m2 = fmaxf(fmaxf(fminf(v0, v1), fminf(v2, v3)), fminf(fmaxf(v0, v1), fmaxf(v2, v3)));
#define RT_MERGE2(CTRL) { const float o1 = dppf<CTRL>(m1), o2 = dppf<CTRL>(m2); \
          const float n1 = fmaxf(m1, o1), n2 = fmaxf(fminf(m1, o1), fmaxf(m2, o2)); m1 = n1; m2 = n2; }
        RT_MERGE2(0xB1) RT_MERGE2(0x4E) RT_MERGE2(0x141)
#undef RT_MERGE2
        const float gsc = m1 + m2;
        const int g = lane >> 3;
        int rank = 0;
#pragma unroll
        for (int gp = 0; gp < 8; ++gp) {
          const float og = shu(gsc, gp * 8);
          rank += (og > gsc || (og == gsc && gp < g)) ? 1 : 0;
        }
        if (rank >= 4) { v0 = -INFINITY; v1 = -INFINITY; v2 = -INFINITY; v3 = -INFINITY; }
        int mye = 0;
        float wsel = 0.f;
#pragma unroll
        for (int k = 0; k < 8; ++k) {
          float bv = v0; int bi = lane * 4;
          if (v1 > bv) { bv = v1; bi = lane * 4 + 1; }
          if (v2 > bv) { bv = v2; bi = lane * 4 + 2; }
          if (v3 > bv) { bv = v3; bi = lane * 4 + 3; }
#define RT_AMX(CTRL) { const float ov = dppf<CTRL>(bv); const int oi = dppi<CTRL>(bi); \
            if (ov > bv || (ov == bv && oi < bi)) { bv = ov; bi = oi; } }
          RT_AMX(0xB1) RT_AMX(0x4E) RT_AMX(0x141) RT_AMX(0x140)
#undef RT_AMX
          {
            float fb = shu(bv, 0); int fi = __builtin_amdgcn_readlane(bi, 0);
#pragma unroll
            for (int k2 = 1; k2 < 4; ++k2) {
              const float ov = shu(bv, 16 * k2); const int oi = __builtin_amdgcn_readlane(bi, 16 * k2);
              if (ov > fb || (ov == fb && oi < fi)) { fb = ov; fi = oi; }
            }
            bv = fb; bi = fi;
          }
          if (bi == lane * 4 + 0) v0 = -INFINITY;
          if (bi == lane * 4 + 1) v1 = -INFINITY;
          if (bi == lane * 4 + 2) v2 = -INFINITY;
          if (bi == lane * 4 + 3) v3 = -INFINITY;
          if (lane == k) mye = bi;
          {
            const int sub_ = bi & 3;
            const float ssel = (sub_ == 0) ? s0 : (sub_ == 1 ? s1 : (sub_ == 2 ? s2 : s3));
            const float wk = shu(ssel, bi >> 2);
            if (lane == k) wsel = wk;
          }
        }
        const float wv = (lane < 8) ? wsel : 0.f;
        const float wsum = wave_sum(wv);
        if (rr != w && lane < 8) {
          p.LTOK[(size_t)pmye * CAP + ppos] = prow;
          p.LW[(size_t)pmye * CAP + ppos] = pwv;
          p.TOKSLOT[(size_t)prow * 8 + lane] = pmye * CAP + ppos;
        }
        if (lane < 8) ppos = atomicAdd(&cnt[mye], 1);
        prow = row; pmye = mye; pwv = wv * (2.5f / wsum);
      }
      if (lane < 8) {
        p.LTOK[(size_t)pmye * CAP + ppos] = prow;
        p.LW[(size_t)pmye * CAP + ppos] = pwv;
        p.TOKSLOT[(size_t)prow * 8 + lane] = pmye * CAP + ppos;
      }
    }
  }
  {
    const int nM = nrows / 256;
    int* sidx = (int*)(smem + 131072 + 2056);
    int nextt = (otid() == 0) ? atomicAdd(&p.WQ[4 + l], 1) : 0;
    for (;;) {
      __syncthreads();
      if (otid() == 0) *sidx = nextt;
      __syncthreads();
      const int it = __builtin_amdgcn_readfirstlane(*sidx);
      if (it >= nM * 2) break;
      if (otid() == 0) nextt = atomicAdd(&p.WQ[4 + l], 1);
      int pm, pn;
      g8_tile(it, nM, 2, pm, pn);
      u16* AS_ = p.ACTSH;
      gemm256<true, false, 1>(p.HN, p.HN, 1 << 30, DM, p.ShGuT + (size_t)l * 512 * 1024, DM, pm * 256, pn * 256, smem,
                    [&](int row, int ac, const float4& g, const float4& u) {
                      *(uint2*)(AS_ + (size_t)row * 256 + ac) = make_uint2(pk2bf(siluf_(g.x) * u.x, siluf_(g.y) * u.y), pk2bf(siluf_(g.z) * u.z, siluf_(g.w) * u.w));
                    });
    }
  }
  convert_experts(p, l, smem);
}

__device__ __forceinline__ int expert_offsets(const int* cnt, int* offs, int* tl) {
  __syncthreads();
  if (threadIdx.x < 256) tl[threadIdx.x] = cnt[threadIdx.x];
  __syncthreads();
  if (threadIdx.x == 0) {
    int o = 0, t = 0;
#pragma unroll 8
    for (int e = 0; e < 256; ++e) { const int c = tl[e]; offs[e] = o; tl[e] = t; o += c; t += (c + 255) >> 8; }
    offs[256] = o; tl[256] = t;
  }
  __syncthreads();
  return tl[256];
}
__device__ __forceinline__ int find_expert(const int* tl, int tile) {
  int lo = 0, hi = 255;
  while (lo < hi) { const int mid = (lo + hi + 1) >> 1; if (tl[mid] <= tile) lo = mid; else hi = mid - 1; }
  return lo;
}

__device__ __forceinline__ void phase_gu(PR p, int l, unsigned char* smem) {
  int* offs = (int*)(smem + 131072);
  int* tl = offs + 257;
  const int* cnt = p.CNT + l * 256;
  const int ntile = expert_offsets(cnt, offs, tl);
  {
    TileIter ti;
    for (int it = ti.next(ntile * 2); it >= 0; it = ti.next(ntile * 2)) {
      const int tile = it >> 1, nt = it & 1;
      const int e = __builtin_amdgcn_readfirstlane(find_expert(tl, tile));
      const int mt = tile - __builtin_amdgcn_readfirstlane(tl[e]);
      const int ce = __builtin_amdgcn_readfirstlane(cnt[e]);
      const int nvalid = min(256, ce - mt * 256);
      const int obase = __builtin_amdgcn_readfirstlane(offs[e]) + mt * 256;
      u16* ACT_ = p.ACT;
      const float* LW_ = p.LW + (size_t)e * CAP + mt * 256;
      gemm256<true, true, 1>(p.HN, p.HN, 1 << 30, DM, p.EGU + (size_t)e * 512 * 1024, DM, 0, nt * 256, smem,
                          [&](int row, int ac, const float4& g, const float4& u) {
                            if (row < nvalid) {
                              const float w_ = LW_[row];
                              *(uint2*)(ACT_ + (size_t)(obase + row) * 256 + ac) =
                                  make_uint2(pk2bf(siluf_(g.x) * u.x * w_, siluf_(g.y) * u.y * w_), pk2bf(siluf_(g.z) * u.z * w_, siluf_(g.w) * u.w * w_));
                            }
                          },
                          p.LTOK + (size_t)e * CAP + mt * 256, nvalid);
    }
  }
  {
    const int nM = ((l == 0) ? NROW : NLAT) / 256;
    int* sidx = (int*)(smem + 131072 + 2056);
    int nextt = (otid() == 0) ? atomicAdd(&p.WQ[2 + l], 1) : 0;
    for (;;) {
      __syncthreads();
      if (otid() == 0) *sidx = nextt;
      __syncthreads();
      const int it = __builtin_amdgcn_readfirstlane(*sidx);
      if (it >= nM * 4) break;
      if (otid() == 0) nextt = atomicAdd(&p.WQ[2 + l], 1);
      int pm, pn;
      g8_tile(it, nM, 4, pm, pn);
      u16* F_ = p.FSH;
      gemm256<false, false, 1>(p.ACTSH, p.ACTSH, 1 << 30, 256, p.ShDnT + (size_t)l * 1024 * 256, 256, pm * 256, pn * 256, smem,
                     [&](int row, int col, const float4& v, const float4&) {
                       *(uint2*)(F_ + (size_t)row * DM + col) = make_uint2(pk2bf(v.x, v.y), pk2bf(v.z, v.w));
                     });
    }
  }
}

__device__ __forceinline__ void phase_down(PR p, int l, unsigned char* smem) {
  int* offs = (int*)(smem + 131072);
  int* tl = offs + 257;
  const int* cnt = p.CNT + l * 256;
  const int ntile = expert_offsets(cnt, offs, tl);
  TileIter ti;
  for (int it = ti.next(ntile * 4); it >= 0; it = ti.next(ntile * 4)) {
    const int tile = it >> 2, nt = it & 3;
    const int e = __builtin_amdgcn_readfirstlane(find_expert(tl, tile));
    const int mt = tile - __builtin_amdgcn_readfirstlane(tl[e]);
    const int ce = __builtin_amdgcn_readfirstlane(cnt[e]);
    const int nvalid = min(256, ce - mt * 256);
    const int obase = __builtin_amdgcn_readfirstlane(offs[e]) + mt * 256;
    u16* YR_ = p.YR;
    gemm256<false, false, 1>(p.ACT, p.ACT, 1 << 30, 256, p.EDN + (size_t)e * 1024 * 256, 256, obase, nt * 256, smem,
                          [&](int row, int col, const float4& v, const float4&) {
                            if (row - obase < nvalid) *(uint2*)(YR_ + (size_t)row * DM + col) = make_uint2(pk2bf(v.x, v.y), pk2bf(v.z, v.w));
                          },
                          nullptr, nvalid);
  }
}

__device__ __forceinline__ void phase_post2(PR p, int l, unsigned char* smem) {
  int* offs = (int*)smem;
  int* tl = offs + 257;
  expert_offsets(p.CNT + l * 256, offs, tl);
  const int tid_ = otid();
  const int lane = tid_ & 63;
  const int gw = blockIdx.x * 8 + (tid_ >> 6), nw = gridDim.x * 8;
  const float* ng3 = p.norm_g + (l * 4 + 3) * DM;
  const int nrows = (l == 0) ? NROW : NLAT;
  int slot_next = (gw < nrows && lane < 8) ? p.TOKSLOT[(size_t)gw * 8 + lane] : 0;
  for (int r = gw; r < nrows; r += nw) {
    const float* mod = p.MOD + (l * 3 + mod_index(r)) * 6144;
    const int slotv = slot_next;
    if (r + nw < nrows && lane < 8) slot_next = p.TOKSLOT[(size_t)(r + nw) * 8 + lane];
    uint2 fb[4], yb[8][4];
#pragma unroll
    for (int q = 0; q < 4; ++q) { const u32x2v t_ = __builtin_nontemporal_load((const u32x2v*)(p.FSH + (size_t)r * DM + q * 256 + lane * 4)); fb[q] = make_uint2(t_.x, t_.y); }
#pragma unroll
    for (int k = 0; k < 8; ++k) {
      const int v = __builtin_amdgcn_readlane(slotv, k);
      const int e = v / CAP, pos = v - e * CAP;
      const u16* yr = p.YR + (size_t)(offs[e] + pos) * DM;
#pragma unroll
      for (int q = 0; q < 4; ++q) { const u32x2v t_ = __builtin_nontemporal_load((const u32x2v*)(yr + q * 256 + lane * 4)); yb[k][q] = make_uint2(t_.x, t_.y); }
    }
    float4 fv[4];
#pragma unroll
    for (int q = 0; q < 4; ++q) {
      fv[q] = make_float4(bf2f((u16)(fb[q].x & 0xFFFF)), bf2f((u16)(fb[q].x >> 16)), bf2f((u16)(fb[q].y & 0xFFFF)), bf2f((u16)(fb[q].y >> 16)));
#pragma unroll
      for (int k = 0; k < 8; ++k) {
        fv[q].x += bf2f((u16)(yb[k][q].x & 0xFFFF)); fv[q].y += bf2f((u16)(yb[k][q].x >> 16));
        fv[q].z += bf2f((u16)(yb[k][q].y & 0xFFFF)); fv[q].w += bf2f((u16)(yb[k][q].y >> 16));
      }
    }
    float ss = 0.f;
#pragma unroll
    for (int q = 0; q < 4; ++q) ss += fv[q].x * fv[q].x + fv[q].y * fv[q].y + fv[q].z * fv[q].z + fv[q].w * fv[q].w;
    ss = wave_sum(ss);
    const float rs = rsqrtf(ss * (1.f / DM) + EPSV);
    float s2 = 0.f;
#pragma unroll
    for (int q = 0; q < 4; ++q) {
      const int e = q * 256 + lane * 4;
      const float4 gv = *(const float4*)(ng3 + e);
      const float4 g2 = *(const float4*)(mod + 5120 + e);
      float4 xx = ldx4(p.X + (size_t)r * DM + e);
      xx.x += g2.x * (fv[q].x * rs * gv.x); xx.y += g2.y * (fv[q].y * rs * gv.y);
      xx.z += g2.z * (fv[q].z * rs * gv.z); xx.w += g2.w * (fv[q].w * rs * gv.w);
      if (l == 1) *(float4*)(p.out + (size_t)r * DM + e) = xx;
      else stx4(p.X + (size_t)r * DM + e, xx);
      fv[q] = xx;
      s2 += xx.x * xx.x + xx.y * xx.y + xx.z * xx.z + xx.w * xx.w;
    }
    if (l == 0) {
      s2 = wave_sum(s2);
      const float rs2 = rsqrtf(s2 * (1.f / DM) + EPSV);
      const float* gn = p.norm_g + (1 * 4 + 0) * DM;
      const float* mod1 = p.MOD + (1 * 3 + mod_index(r)) * 6144;
#pragma unroll
      for (int q = 0; q < 4; ++q) {
        const int e = q * 256 + lane * 4;
        const float4 gv = *(const float4*)(gn + e);
        const float4 sh = *(const float4*)(mod1 + e);
        const float4 sc = *(const float4*)(mod1 + 1024 + e);
        uint2 o;
        o.x = pk2bf(fv[q].x * rs2 * gv.x * (1.f + sc.x) + sh.x, fv[q].y * rs2 * gv.y * (1.f + sc.y) + sh.y);
        o.y = pk2bf(fv[q].z * rs2 * gv.z * (1.f + sc.z) + sh.z, fv[q].w * rs2 * gv.w * (1.f + sc.w) + sh.w);
        *(uint2*)(p.HN + (size_t)r * DM + e) = o;
      }
    }
  }
}

#define SMEM_BYTES (16384 * 8 + 256 * 8 + 64)

__device__ __forceinline__ void grid_barrier(PR p, unsigned char* smem) {
  XcdBarrier b;
  b.bar = p.bar; b.x = xb_xcc_id(); b.st = (volatile LAS unsigned*)(smem + SMEM_BYTES);
  xcd_barrier(b);
}

__global__ void __launch_bounds__(NTH, 2) k_fused(Params p_unused) {
  extern __shared__ __align__(16) unsigned char smem[];
  PR p = *(const __attribute__((address_space(4))) Params*)__builtin_amdgcn_kernarg_segment_ptr();
  uint4* xbw = (uint4*)(smem + SMEM_BYTES);
  if (threadIdx.x == 0) *xbw = make_uint4(0u, 0u, 0u, 0u);
  __syncthreads();
  (void)xcd_barrier_post(p.bar, (volatile LAS unsigned*)xbw);
  int* xinfo = (int*)(smem + XINFO_OFF);
  if (threadIdx.x == 0) xinfo[1] = (int)atomicAdd(p.bar + XCEN_WORD + xb_xcc_id(), 1u);
  phase_prologue(p, smem);
  grid_barrier(p, smem);
  if (threadIdx.x == 0) {
    const unsigned me = xb_xcc_id();
    unsigned nxp = 0, ord = 0, mine = 0, tot = 0; bool even = true;
    for (unsigned j = 0; j < 16; ++j) {
      const unsigned c = __hip_atomic_load(p.bar + XCEN_WORD + j, __ATOMIC_RELAXED, __HIP_MEMORY_SCOPE_AGENT);
      if (c) { ++nxp; if (j < me) ++ord; }
      if (j == me) mine = c;
      tot += c;
    }
    for (unsigned j = 0; j < 16; ++j) {
      const unsigned c = __hip_atomic_load(p.bar + XCEN_WORD + j, __ATOMIC_RELAXED, __HIP_MEMORY_SCOPE_AGENT);
      if (c && c != mine) even = false;
    }
    even = even && (tot == gridDim.x) && (mine > 0);
    xinfo[0] = (int)ord; xinfo[2] = even ? (int)mine : 0; xinfo[3] = (int)nxp;
  }
  __syncthreads();
#define LAYER_BODY(l) \
    if (l == 0) { phase_norm1(p, l); grid_barrier(p, smem); } \
    phase_inproj(p, l, smem); \
    grid_barrier(p, smem); \
    phase_mixA(p, l, smem); \
    grid_barrier(p, smem); \
    phase_scan(p, l); \
    grid_barrier(p, smem); \
    phase_mixC(p, l, smem); \
    grid_barrier(p, smem); \
    phase_outproj(p, l, smem); \
    grid_barrier(p, smem); \
    phase_post1(p, l); \
    grid_barrier(p, smem); \
    phase_router(p, l, smem); \
    grid_barrier(p, smem); \
    phase_gu(p, l, smem); \
    grid_barrier(p, smem); \
    phase_down(p, l, smem); \
    grid_barrier(p, smem); \
    phase_post2(p, l, smem); \
    grid_barrier(p, smem);
  LAYER_BODY(0)
  LAYER_BODY(1)
#undef LAYER_BODY
}

extern "C" void kernel_launch(void* const* d_in, const int* in_sizes, int n_in, void* d_out, int out_size, void* d_ws,
                              size_t ws_size, hipStream_t stream) {
  Params p{};
  const float* const* in = (const float* const*)d_in;
  p.x = in[0]; p.c = in[1]; p.ctx = in[2]; p.c_ctx = in[3]; p.ada_w = in[4]; p.ada_b = in[5]; p.norm_g = in[6];
  p.w_in = in[7]; p.w_out = in[8]; p.hy_conv_w = in[9]; p.hy_conv_b = in[10]; p.hy_w1 = in[11]; p.hy_b1 = in[12];
  p.hy_w2 = in[13]; p.hy_b2 = in[14]; p.hy_w3 = in[15]; p.hy_freq = in[16]; p.hy_bias = in[17]; p.hy_norm = in[18];
  p.hg_lb_logits = in[19]; p.hg_norm = in[20]; p.gla_a_up = in[21]; p.gla_a_b = in[22]; p.gla_norm = in[23];
  p.ml_conv_w = in[24]; p.ml_conv_b = in[25]; p.ml_gate_b = in[26]; p.ml_norm = in[27];
  p.router_w = in[28]; p.router_b = in[29]; p.exp_w_gu = in[30]; p.exp_w_down = in[31]; p.sh_w_gu = in[32]; p.sh_w_down = in[33];
  p.out = (float*)d_out;
  size_t off = 0;
  auto alloc = [&](size_t bytes) { void* r = (char*)d_ws + off; off += (bytes + 255) & ~(size_t)255; return r; };
  p.bar = (unsigned*)alloc(16384);
  p.X = (u16*)alloc((size_t)NROW * DM * 4);
  p.MOD = (float*)alloc(2 * 3 * 6144 * 4);
  p.LBv = (float*)alloc(2 * 256 * 4);
  p.HFT = (float*)alloc((size_t)2 * 1024 * 8192 * 4);
  p.HFTC = (float*)alloc((size_t)1024 * 256 * 4);
  p.PT = (u16*)alloc((size_t)768 * NROW * 4);
  p.HS = (uint32_t*)alloc((size_t)256 * 2 * 16384 * 8);
  p.ZS = (float2*)alloc((size_t)256 * 8192 * 8);
  p.HN = (u16*)alloc((size_t)NROW * DM * 2);
  p.P = (u16*)alloc((size_t)NROW * DIN * 4);
  p.YMIX = (u16*)alloc((size_t)NROW * DM * 2);
  p.YO = (float*)alloc((size_t)NROW * DM * 4);
  p.HYRAW = (float*)alloc((size_t)NROW * 256 * 4);
  p.SBHG = (u16*)alloc((size_t)16 * NCH * 4096 * 2);
  p.SBGL = (u16*)alloc((size_t)16 * NCH * 2048 * 2);
  p.SBML = (u16*)alloc((size_t)16 * NCH * 4096 * 2);
  p.NBML = (float*)alloc((size_t)16 * NCH * 64 * 4);
  p.DCHG = (float*)alloc((size_t)16 * NCH * 64 * 4);
  p.DCGL = (float*)alloc((size_t)16 * NCH * 32 * 4);
  p.DCML = (float*)alloc((size_t)16 * NCH * 64 * 4);
  p.CNT = (int*)alloc(2 * 256 * 4);
  p.WQ = (int*)alloc(256);
  p.LTOK = (int*)alloc((size_t)256 * CAP * 4);
  p.LW = (float*)alloc((size_t)256 * CAP * 4);
  p.TOKSLOT = (int*)alloc((size_t)NROW * 8 * 4);
  p.ACT = (u16*)alloc((size_t)(NSLOT + 512) * 256 * 2);
  p.ACTSH = (u16*)alloc((size_t)NROW * 256 * 2);
  p.FSH = (u16*)alloc((size_t)NROW * DM * 2);
  p.YOB = (u16*)alloc((size_t)NROW * DM * 2);
  p.YR = (u16*)alloc((size_t)(NSLOT + 512) * DM * 2);
  p.WinT = (u16*)alloc((size_t)2 * 4096 * 1024 * 2);
  p.WoutT = (u16*)alloc((size_t)2 * 1024 * 1024 * 2);
  p.ShGuT = (u16*)alloc((size_t)2 * 512 * 1024 * 2);
  p.ShDnT = (u16*)alloc((size_t)2 * 1024 * 256 * 2);
  p.RWT = (u16*)alloc((size_t)2 * 256 * 3072 * 2);
  p.HLO = (u16*)alloc((size_t)NROW * DM * 2);
  p.EGU = (u16*)alloc((size_t)256 * 512 * 1024 * 2);
  p.EDN = (u16*)alloc((size_t)256 * 1024 * 256 * 2);
  if (off > ws_size) { fprintf(stderr, "workspace too small: need %zu have %zu\n", off, ws_size); return; }
  static int grid = 0;
  const size_t dyn = SMEM_BYTES + 16 + 64;
  if (!grid) {
    int dev = 0, cus = 0, per_cu = 0;
    hipGetDevice(&dev);
    hipDeviceGetAttribute(&cus, hipDeviceAttributeMultiprocessorCount, dev);
    (void)hipFuncSetAttribute((const void*)k_fused, hipFuncAttributeMaxDynamicSharedMemorySize, (int)dyn);
    (void)hipOccupancyMaxActiveBlocksPerMultiprocessor(&per_cu, k_fused, NTH, dyn);
    if (per_cu < 1) { fprintf(stderr, "occupancy query says 0 blocks per CU\n"); per_cu = 1; }
    grid = cus;
  }
  (void)hipMemsetAsync(p.bar, 0, 4096 * sizeof(unsigned), stream);
  hipLaunchKernelGGL(k_fused, dim3(grid), dim3(NTH), dyn, stream, p);
}
```

```cpp
#include <hip/hip_runtime.h>
#include <stdint.h>
#include <stdio.h>

#ifndef FUSED
#define FUSED 0
#endif

typedef unsigned short u16;
typedef __attribute__((ext_vector_type(8))) short bf16x8;
typedef __attribute__((ext_vector_type(4))) float f32x4;
typedef float f32x8v __attribute__((ext_vector_type(8)));
typedef float f32x16v __attribute__((ext_vector_type(16)));
typedef __attribute__((ext_vector_type(2))) unsigned u32x2v;
typedef __attribute__((ext_vector_type(16))) unsigned u32x16v;
typedef __attribute__((ext_vector_type(2))) float f32x2v;

#define XB_TMO      128
#define XB_XCNT(j)  (256  + 64 * (j))
#define XB_XSUB(j)  (1280 + 64 * (j))
#define XB_XGEN(j)  (2304 + 64 * (j))
#define XB_TOP      3328
#define XB_TOPGEN   3392
#define XCD_BAR_WORDS 3456
#define XB_SPIN_CAP (1u << 18)
#define LAS __attribute__((address_space(3)))

__device__ __forceinline__ unsigned xb_ld(unsigned* p)              { return __hip_atomic_load(p, __ATOMIC_RELAXED, __HIP_MEMORY_SCOPE_AGENT); }
__device__ __forceinline__ unsigned xb_add(unsigned* p, unsigned v) { return __hip_atomic_fetch_add(p, v, __ATOMIC_RELAXED, __HIP_MEMORY_SCOPE_AGENT); }
__device__ __forceinline__ unsigned xb_xcc_id() { return (unsigned)__builtin_amdgcn_s_getreg((3 << 11) | 20) & 0xFu; }
#define XB_SPIN(cond, bar) do { unsigned _sp = 0; while (cond) { __builtin_amdgcn_s_sleep(1); \
    if ((++_sp & 255u) == 0u) { if (xb_ld(&(bar)[XB_TMO])) break; if (_sp > XB_SPIN_CAP) { atomicAdd(&(bar)[XB_TMO], 1u); break; } } } } while (0)

struct XcdBarrier {
    unsigned* bar; unsigned x;
    volatile LAS unsigned* st;
};

__device__ __forceinline__ XcdBarrier xcd_barrier_post(unsigned* bar, volatile LAS unsigned* st) {
    XcdBarrier b; b.bar = bar; b.x = xb_xcc_id(); b.st = st;
    if (threadIdx.x == 0) (void)xb_add(&bar[XB_XCNT(b.x)], 1u);
    return b;
}
__device__ __forceinline__ void xcd_barrier_complete(unsigned* bar, unsigned x, unsigned& nloc, unsigned& nx) {
    const unsigned G = gridDim.x * gridDim.y * gridDim.z;
    unsigned sum, cnt, mine, sp = 0u;
    for (;;) {
        sum = 0u; cnt = 0u; mine = 0u;
#pragma unroll
        for (unsigned j = 0; j < 16; ++j) { const unsigned c = xb_ld(&bar[XB_XCNT(j)]); sum += c; cnt += (c > 0u) ? 1u : 0u; mine = (j == x) ? c : mine; }
        if (sum == G) break;
        __builtin_amdgcn_s_sleep(1);
        if ((++sp & 255u) == 0u) { if (xb_ld(&bar[XB_TMO])) break; if (sp > XB_SPIN_CAP) { atomicAdd(&bar[XB_TMO], 1u); break; } }
    }
    nloc = mine > 0u ? mine : 1u; nx = cnt > 0u ? cnt : 1u;
}

__device__ __forceinline__ void xcd_barrier(const XcdBarrier& b) {
    asm volatile("s_waitcnt vmcnt(0)" ::: "memory");
    __syncthreads();
    if (threadIdx.x == 0) {
        unsigned* bar = b.bar;
        __builtin_amdgcn_s_waitcnt(0);
        unsigned nloc = b.st[0], nx = b.st[1];
        if (nloc == 0u) { xcd_barrier_complete(bar, b.x, nloc, nx); b.st[0] = nloc; b.st[1] = nx; }
        const unsigned old = xb_add(&bar[XB_XSUB(b.x)], 1u);
        const unsigned gen = old / nloc;
        if (old + 1u == (gen + 1u) * nloc) {
            __builtin_amdgcn_fence(__ATOMIC_RELEASE, "agent");
            asm volatile("s_waitcnt vmcnt(0)" ::: "memory");
            const unsigned og = xb_add(&bar[XB_TOP], 1u);
            const unsigned tg = og / nx;
            if (og + 1u == (tg + 1u) * nx) xb_add(&bar[XB_TOPGEN], 1u);
            else XB_SPIN(xb_ld(&bar[XB_TOPGEN]) == tg, bar);
            __builtin_amdgcn_fence(__ATOMIC_ACQUIRE, "agent");
            xb_add(&bar[XB_XGEN(b.x)], 1u);
            asm volatile("s_waitcnt vmcnt(0)" ::: "memory");
        } else {
            XB_SPIN(xb_ld(&bar[XB_XGEN(b.x)]) == gen, bar);
            __builtin_amdgcn_fence(__ATOMIC_ACQUIRE, "agent");
            asm volatile("s_waitcnt vmcnt(0)" ::: "memory");
        }
    }
    __syncthreads();
}


#define DM 1024
#define SEQL 8192
#define CTXL 256
#define NLAT 16384
#define NCTXR 512
#define NROW 16896
#define DIN 3888
#define NTH 512
#define NCH 132
#define CAP 16896
#define NSLOT (NROW * 8)
#define EPSV 1e-6f

struct Params {
  const float *x, *c, *ctx, *c_ctx, *ada_w, *ada_b, *norm_g, *w_in, *w_out;
  const float *hy_conv_w, *hy_conv_b, *hy_w1, *hy_b1, *hy_w2, *hy_b2, *hy_w3, *hy_freq, *hy_bias, *hy_norm;
  const float *hg_lb_logits, *hg_norm, *gla_a_up, *gla_a_b, *gla_norm;
  const float *ml_conv_w, *ml_conv_b, *ml_gate_b, *ml_norm;
  const float *router_w, *router_b, *exp_w_gu, *exp_w_down, *sh_w_gu, *sh_w_down;
  float* out;
  unsigned* bar;
  u16* X;
  float* MOD;
  float* LBv;
  float* HFT;
  float* HFTC;
  u16* PT;
  uint32_t* HS;
  float2* ZS;
  u16* HN;
  u16* P;
  u16* YMIX;
  float* YO;
  float* HYRAW;
  u16* SBHG;
  u16* SBGL;
  u16* SBML;
  float* NBML;
  float* DCHG;
  float* DCGL;
  float* DCML;
  int* CNT;
  int* WQ;
  int* LTOK;
  float* LW;
  int* TOKSLOT;
  u16* ACT;
  u16* ACTSH;
  u16* FSH;
  u16* YOB;
  u16* YR;
  u16* WinT;
  u16* WoutT;
  u16* ShGuT;
  u16* ShDnT;
  u16* RWT;
  u16* HLO;
  u16* EGU;
  u16* EDN;
};

typedef const __attribute__((address_space(4))) Params& PR;
__device__ __forceinline__ int otid() { int t = threadIdx.x; asm volatile("" : "+v"(t)); return t; }
typedef __bf16 bf16x2_t __attribute__((ext_vector_type(2)));
typedef float float2_t __attribute__((ext_vector_type(2)));
__device__ __forceinline__ uint32_t pk2bf(float a, float b) {
  float2_t v = {a, b};
  bf16x2_t r = __builtin_convertvector(v, bf16x2_t);
  return *(uint32_t*)&r;
}
__device__ __forceinline__ u16 f2bf(float f) { return (u16)(pk2bf(f, 0.f) & 0xFFFFu); }
__device__ __forceinline__ float bf2f(u16 h) { return __uint_as_float(((uint32_t)h) << 16); }
__device__ __forceinline__ float sigmoidf_(float z) { return 1.f / (1.f + expf(-z)); }
__device__ __forceinline__ float siluf_(float z) { return z / (1.f + expf(-z)); }
__device__ __forceinline__ float logsigmoidf_(float z) { return (z >= 0.f) ? -log1pf(expf(-z)) : (z - log1pf(expf(z))); }
__device__ __forceinline__ float fexp(float x) { return __expf(x); }
__device__ __forceinline__ float frcp(float x) { return __builtin_amdgcn_rcpf(x); }
__device__ __forceinline__ float fsigmoid(float z) { return frcp(1.f + __expf(-z)); }
__device__ __forceinline__ float fsilu(float z) { return z * frcp(1.f + __expf(-z)); }
__device__ __forceinline__ float flogsigmoid(float z) { return fminf(z, 0.f) - __logf(1.f + __expf(-fabsf(z))); }
__device__ __forceinline__ int olane() {
  int l = (int)__builtin_amdgcn_mbcnt_hi(~0u, __builtin_amdgcn_mbcnt_lo(~0u, 0u));
  asm volatile("" : "+v"(l));
  return l;
}
__device__ __forceinline__ float shx(float v, int m, int lane) { return __int_as_float(__builtin_amdgcn_ds_bpermute((lane ^ m) << 2, __float_as_int(v))); }
__device__ __forceinline__ int shxi(int v, int m, int lane) { return __builtin_amdgcn_ds_bpermute((lane ^ m) << 2, v); }
__device__ __forceinline__ float shl_(float v, int src) { return __int_as_float(__builtin_amdgcn_ds_bpermute(src << 2, __float_as_int(v))); }
__device__ __forceinline__ float shu(float v, int src) { return __int_as_float(__builtin_amdgcn_readlane(__float_as_int(v), src)); }
template <int CTRL> __device__ __forceinline__ int dppi(int v) { return __builtin_amdgcn_update_dpp(0, v, CTRL, 0xF, 0xF, false); }
template <int CTRL> __device__ __forceinline__ float dppf(float v) {
  return __int_as_float(__builtin_amdgcn_update_dpp(0, __float_as_int(v), CTRL, 0xF, 0xF, false));
}
__device__ __forceinline__ float wave_sum(float v) {
  v += dppf<0xB1>(v);
  v += dppf<0x4E>(v);
  v += dppf<0x141>(v);
  v += dppf<0x140>(v);
  return (shu(v, 0) + shu(v, 16)) + (shu(v, 32) + shu(v, 48));
}
__device__ __forceinline__ float block_sum(float v, float* red) {
  v = wave_sum(v);
  __syncthreads();
  if ((threadIdx.x & 63) == 0) red[threadIdx.x >> 6] = v;
  __syncthreads();
  float s = 0.f;
#pragma unroll
  for (int i = 0; i < 8; ++i) s += red[i];
  return s;
}

#define G2_LD 40
struct GemmSmem { u16 As[2][128 * G2_LD]; u16 Bs[2][256 * G2_LD]; };

template <class BCOL>
__device__ __forceinline__ void gemm_tile(const u16* arow, const float* __restrict__ B, int ldb, const BCOL& bcol, int K,
                                          GemmSmem* sm, f32x4 (&acc)[4][4]) {
  const int tid = otid(), lane = tid & 63, w = tid >> 6, wm = w >> 2, wn = w & 3;
#pragma unroll
  for (int i = 0; i < 4; ++i)
#pragma unroll
    for (int j = 0; j < 4; ++j) acc[i][j] = (f32x4){0.f, 0.f, 0.f, 0.f};
  const int akc = tid & 3, ar = tid >> 2;
  const int kg = tid & 7, ng = tid >> 3;
  const int bc = bcol(ng * 4);
  const float* bp = B + (size_t)(kg * 4) * ldb + bc;
  const u16* ap = arow + akc * 8;
  uint4 ra0, ra1, ra2, ra3;
  float4 rb00, rb01, rb02, rb03, rb10, rb11, rb12, rb13, rb20, rb21, rb22, rb23, rb30, rb31, rb32, rb33;
  const int nk = K >> 5;
#define G2_RB(S, J) rb##S##J
#define G2_LOAD(S, KT)                                                   \
  {                                                                      \
    ra##S = *(const uint4*)(ap + (KT) * 32);                             \
    G2_RB(S, 0) = *(const float4*)(bp + (size_t)((KT) * 32 + 0) * ldb);     \
    G2_RB(S, 1) = *(const float4*)(bp + (size_t)((KT) * 32 + 1) * ldb);     \
    G2_RB(S, 2) = *(const float4*)(bp + (size_t)((KT) * 32 + 2) * ldb);     \
    G2_RB(S, 3) = *(const float4*)(bp + (size_t)((KT) * 32 + 3) * ldb);     \
  }
#define G2_STORE(S, BUF)                                                                                                     \
  {                                                                                                                          \
    *(uint4*)(&sm->As[BUF][ar * G2_LD + akc * 8]) = ra##S;                                                                   \
    *(uint2*)(&sm->Bs[BUF][(ng * 4 + 0) * G2_LD + kg * 4]) = make_uint2(pk2bf(G2_RB(S, 0).x, G2_RB(S, 1).x), pk2bf(G2_RB(S, 2).x, G2_RB(S, 3).x)); \
    *(uint2*)(&sm->Bs[BUF][(ng * 4 + 1) * G2_LD + kg * 4]) = make_uint2(pk2bf(G2_RB(S, 0).y, G2_RB(S, 1).y), pk2bf(G2_RB(S, 2).y, G2_RB(S, 3).y)); \
    *(uint2*)(&sm->Bs[BUF][(ng * 4 + 2) * G2_LD + kg * 4]) = make_uint2(pk2bf(G2_RB(S, 0).z, G2_RB(S, 1).z), pk2bf(G2_RB(S, 2).z, G2_RB(S, 3).z)); \
    *(uint2*)(&sm->Bs[BUF][(ng * 4 + 3) * G2_LD + kg * 4]) = make_uint2(pk2bf(G2_RB(S, 0).w, G2_RB(S, 1).w), pk2bf(G2_RB(S, 2).w, G2_RB(S, 3).w)); \
  }
#define G2_COMPUTE(BUF)                                                                                                      \
  {                                                                                                                          \
    bf16x8 a_[4], b_[4];                                                                                                     \
    _Pragma("unroll") for (int i = 0; i < 4; ++i) a_[i] = *(const bf16x8*)(&sm->As[BUF][(wm * 64 + i * 16 + (lane & 15)) * G2_LD + (lane >> 4) * 8]); \
    _Pragma("unroll") for (int j = 0; j < 4; ++j) b_[j] = *(const bf16x8*)(&sm->Bs[BUF][(wn * 64 + j * 16 + (lane & 15)) * G2_LD + (lane >> 4) * 8]); \
    _Pragma("unroll") for (int i = 0; i < 4; ++i)                                                                            \
      _Pragma("unroll") for (int j = 0; j < 4; ++j) acc[i][j] = __builtin_amdgcn_mfma_f32_16x16x32_bf16(a_[i], b_[j], acc[i][j], 0, 0, 0); \
  }
#define G2_STEP(U, UN, BUF, BUFN)                      \
  {                                                    \
    const int kt = kt0 + U;                            \
    if (kt + 4 < nk) G2_LOAD(U, kt + 4)                \
    G2_COMPUTE(BUF)                                    \
    if (kt + 1 < nk) G2_STORE(UN, BUFN)                \
    __syncthreads();                                   \
  }
  G2_LOAD(0, 0) G2_LOAD(1, 1) G2_LOAD(2, 2) G2_LOAD(3, 3)
  __syncthreads();
  G2_STORE(0, 0)
  __syncthreads();
  for (int kt0 = 0; kt0 < nk; kt0 += 4) {
    G2_STEP(0, 1, 0, 1)
    G2_STEP(1, 2, 1, 0)
    G2_STEP(2, 3, 0, 1)
    G2_STEP(3, 0, 1, 0)
  }
#undef G2_LOAD
#undef G2_RB
#undef G2_STORE
#undef G2_COMPUTE
#undef G2_STEP
}

#define XINFO_OFF (16384 * 8 + 256 * 8 + 64 + 16)
#define XCEN_WORD 3600
struct TileIter {
  int G, cs, nx, xo, rk, round;
  __device__ __forceinline__ TileIter() : G(gridDim.x), round(0) {
    extern __shared__ __align__(16) unsigned char smem_ti[];
    const int* xi = (const int*)(smem_ti + XINFO_OFF);
    xo = __builtin_amdgcn_readfirstlane(xi[0]); rk = __builtin_amdgcn_readfirstlane(xi[1]);
    cs = __builtin_amdgcn_readfirstlane(xi[2]); nx = __builtin_amdgcn_readfirstlane(xi[3]);
  }
  __device__ __forceinline__ int next(int ntiles) { return __builtin_amdgcn_readfirstlane(next_(ntiles)); }
  __device__ __forceinline__ int next_(int ntiles) {
    for (;;) {
      if (cs == 0) { const int t = blockIdx.x + round * G; ++round; return t < ntiles ? t : -1; }
      const int chunk = round * nx + xo;
      ++round;
      if (chunk * cs >= ntiles) {
        if ((round - 1) * nx * cs >= ntiles) return -1;
        continue;
      }
      const int t = chunk * cs + rk;
      if (t < ntiles) return t;
    }
  }
};

#define G8_HT (128 * 64)
__device__ __forceinline__ int g8_lds_byte(int r, int c) {
  int st = (r >> 4) * 2 + (c >> 5), rr = r & 15, cc = c & 31, ob = rr * 64 + cc * 2;
  return st * 1024 + (ob ^ (((ob >> 9) & 1) << 5));
}
__device__ __forceinline__ void g8_stage_rc(int b, int& R, int& C) {
  int st = b / 1024, sb = b % 1024, swz = sb ^ (((sb >> 9) & 1) << 5);
  R = (st >> 1) * 16 + swz / 64; C = (st & 1) * 32 + (swz % 64) / 2;
}
template <bool PAIR, bool GATHER, int STG, class EPI>
__device__ __forceinline__ void gemm256(const u16* A, const u16* A2, int kswitch, int lda, const u16* Bt, int K, int brow, int bcol,
                                        unsigned char* smem, const EPI& epi, const int* rowtab = nullptr, int nvalid = 256, int nvalidB = 256) {
  const int amask = (lda >> 6) - 1;
  const bool hiv = nvalid > 128;
  const bool hjv = nvalidB > 128;
  int go00 = 0, go01 = 0, go10 = 0, go11 = 0;
  if (GATHER) {
    const int t0 = otid();
    int r0_, r1_, c_;
    g8_stage_rc(t0 * 16, r0_, c_);
    g8_stage_rc(t0 * 16 + 8192, r1_, c_);
    go00 = rowtab[(r0_ < nvalid) ? r0_ : 0] * lda;
    go01 = rowtab[(r1_ < nvalid) ? r1_ : 0] * lda;
    go10 = rowtab[(128 + r0_ < nvalid) ? 128 + r0_ : 0] * lda;
    go11 = rowtab[(128 + r1_ < nvalid) ? 128 + r1_ : 0] * lda;
  }
  u16* shm = (u16*)smem;
#define G8_SA(b, h) (shm + ((b) * 2 + (h)) * G8_HT)
#define G8_SB(b, h) (shm + (4 + (b) * 2 + (h)) * G8_HT)
#define G8_STAGE_B(T, P, BASE, br, kt) do { long _g = (long)(br) * K + (long)(kt) * 64; \
    for (int _i = 0; _i < 2; ++_i) { int _b = (T) * 16 + _i * 8192; int _r, _c; g8_stage_rc(_b, _r, _c); \
      __builtin_amdgcn_global_load_lds((const unsigned*)(BASE + _g + (long)_r * K + _c), \
        (LAS unsigned*)((char*)(P) + _b), 16, 0, 0); } } while (0)
#define G8_STAGE_A(T, P, BASE, br, kt) do { const u16* _ab = ((kt) < kswitch) ? A : A2; long _g = (long)((kt) & amask) * 64; \
    const int _h = ((br) - brow) >> 7; \
    for (int _i = 0; _i < 2; ++_i) { int _b = (T) * 16 + _i * 8192; int _r, _c; g8_stage_rc(_b, _r, _c); \
      const long _ro = GATHER ? (long)(_h == 0 ? (_i == 0 ? go00 : go01) : (_i == 0 ? go10 : go11)) : ((long)(br) + _r) * lda; \
      __builtin_amdgcn_global_load_lds((const unsigned*)(_ab + _g + _ro + _c), \
        (LAS unsigned*)((char*)(P) + _b), 16, 0, 0); } } while (0)
#define G8_STAGE_X(T, P, BASE, br, kt) G8_STAGE_##BASE(T, P, BASE, br, kt)
#define G8_STAGE_Bt G8_STAGE_B
#define G8_STAGE(P, BASE, br, kt) G8_STAGE_X(tx, P, BASE, br, kt)
#define G8_LDA(dst, b, h) for (int m = 0; m < 4; ++m) for (int k = 0; k < 2; ++k) \
    dst[m][k] = *reinterpret_cast<const bf16x8*>((char*)G8_SA(b, h) + g8_lds_byte(wr * 64 + m * 16 + fr, k * 32 + fq * 8))
#define G8_LDB(dst, b, h) for (int n = 0; n < 2; ++n) for (int k = 0; k < 2; ++k) \
    dst[n][k] = *reinterpret_cast<const bf16x8*>((char*)G8_SB(b, h) + g8_lds_byte(wc * 32 + n * 16 + fr, k * 32 + fq * 8))
#define G8_MMA(ai, bj, At, Bt_) do { __builtin_amdgcn_s_setprio(1); \
    for (int m = 0; m < 4; ++m) for (int n = 0; n < 2; ++n) for (int k = 0; k < 2; ++k) \
      acc[ai][bj][m][n] = __builtin_amdgcn_mfma_f32_16x16x32_bf16(At[m][k], Bt_[n][k], acc[ai][bj][m][n], 0, 0, 0); \
    __builtin_amdgcn_s_setprio(0); } while (0)
#define G8_WAIT_V(n) asm volatile("s_waitcnt vmcnt(" #n ")" ::: "memory")
#define G8_WAIT_L(n) asm volatile("s_waitcnt lgkmcnt(" #n ")" ::: "memory")
#define G8_BAR __builtin_amdgcn_s_barrier()
#define G8_SCHED __builtin_amdgcn_sched_barrier(0)
  int tx = otid();
  int wid = tx >> 6, lane = tx & 63, wr = wid >> 2, wc = wid & 3, fr = lane & 15, fq = lane >> 4;
  f32x4 acc[2][2][4][2] = {};
  bf16x8 At[4][2], B0[2][2], B1[2][2];
  const int nt = K / 64;
  G8_WAIT_V(0); G8_WAIT_L(0);
  __syncthreads();
  G8_STAGE(G8_SB(0, 0), Bt, bcol, 0); G8_STAGE(G8_SA(0, 0), A, brow, 0);
  G8_STAGE(G8_SB(0, 1), Bt, bcol + 128, 0); G8_STAGE(G8_SA(0, 1), A, brow + 128, 0);
  if (wr == 1) G8_BAR;
  G8_WAIT_V(4); G8_BAR;
  G8_STAGE(G8_SB(1, 0), Bt, bcol, 1); G8_STAGE(G8_SA(1, 0), A, brow, 1); G8_STAGE(G8_SB(1, 1), Bt, bcol + 128, 1);
  G8_WAIT_V(6); G8_BAR;
  for (int t = 0; t < nt - 2; t += 2) {
    G8_LDB(B0, 0, 0); G8_SCHED; G8_LDA(At, 0, 0); G8_STAGE(G8_SA(1, 1), A, brow + 128, t + 1);
    G8_WAIT_L(8); G8_BAR; G8_WAIT_L(0); G8_MMA(0, 0, At, B0); G8_BAR; G8_SCHED;
    G8_LDB(B1, 0, 1); G8_STAGE(G8_SB(0, 0), Bt, bcol, t + 2);
    G8_BAR; G8_WAIT_L(0); if (hjv) G8_MMA(0, 1, At, B1); G8_BAR;
    G8_LDA(At, 0, 1); G8_STAGE(G8_SA(0, 0), A, brow, t + 2);
    G8_BAR; G8_WAIT_L(0); if (hiv) G8_MMA(1, 0, At, B0); G8_BAR; G8_SCHED;
    G8_STAGE(G8_SB(0, 1), Bt, bcol + 128, t + 2);
    G8_WAIT_V(6); G8_BAR; if (hiv && hjv) G8_MMA(1, 1, At, B1); G8_BAR;
    G8_LDB(B0, 1, 0); G8_SCHED; G8_LDA(At, 1, 0); G8_STAGE(G8_SA(0, 1), A, brow + 128, t + 2);
    G8_WAIT_L(8); G8_BAR; G8_WAIT_L(0); G8_MMA(0, 0, At, B0); G8_BAR; G8_SCHED;
    G8_LDB(B1, 1, 1); G8_STAGE(G8_SB(1, 0), Bt, bcol, t + 3);
    G8_BAR; G8_WAIT_L(0); if (hjv) G8_MMA(0, 1, At, B1); G8_BAR;
    G8_LDA(At, 1, 1); G8_STAGE(G8_SA(1, 0), A, brow, t + 3);
    G8_BAR; G8_WAIT_L(0); if (hiv) G8_MMA(1, 0, At, B0); G8_BAR; G8_SCHED;
    G8_STAGE(G8_SB(1, 1), Bt, bcol + 128, t + 3);
    G8_WAIT_V(6); G8_BAR; if (hiv && hjv) G8_MMA(1, 1, At, B1); G8_BAR;
  }
  int tz = otid(); wid = tz >> 6; lane = tz & 63; wr = wid >> 2; wc = wid & 3; fr = lane & 15; fq = lane >> 4;
  { G8_LDB(B0, 0, 0); G8_WAIT_V(0); G8_LDA(At, 0, 0); G8_STAGE_X(tz, G8_SA(1, 1), A, brow + 128, nt - 1);
    G8_BAR; G8_WAIT_L(0); G8_MMA(0, 0, At, B0); G8_BAR;
    G8_LDB(B1, 0, 1); G8_BAR; G8_WAIT_L(0); if (hjv) G8_MMA(0, 1, At, B1); G8_BAR;
    G8_LDA(At, 0, 1); G8_WAIT_V(4); G8_BAR; G8_WAIT_L(0); if (hiv) G8_MMA(1, 0, At, B0); if (hiv && hjv) G8_MMA(1, 1, At, B1); G8_BAR; }
  { G8_LDB(B0, 1, 0); G8_LDA(At, 1, 0); G8_WAIT_V(2); G8_BAR; G8_WAIT_L(0); G8_MMA(0, 0, At, B0); G8_BAR;
    G8_LDB(B1, 1, 1); G8_WAIT_V(0); G8_BAR; G8_WAIT_L(0); if (hjv) G8_MMA(0, 1, At, B1); G8_BAR;
    G8_LDA(At, 1, 1); G8_BAR; G8_WAIT_L(0); if (hiv) G8_MMA(1, 0, At, B0); if (hiv && hjv) G8_MMA(1, 1, At, B1); G8_BAR; }
  if (wr == 0) G8_BAR;
  if constexpr (STG == 0) {
#pragma unroll
    for (int ai = 0; ai < 2; ++ai)
#pragma unroll
      for (int bj = 0; bj < 2; ++bj)
#pragma unroll
        for (int m = 0; m < 4; ++m) {
          const int row0 = brow + ai * 128 + wr * 64 + m * 16 + fq * 4, col = bcol + bj * 128 + wc * 32 + fr;
          if constexpr (PAIR) epi(row0, col, acc[ai][bj][m][0], acc[ai][bj][m][1]);
          else { epi(row0, col, acc[ai][bj][m][0], acc[ai][bj][m][0]); epi(row0, col + 16, acc[ai][bj][m][1], acc[ai][bj][m][1]); }
        }
  } else {
    float* T = (float*)smem;
#pragma unroll
    for (int ai = 0; ai < 2; ++ai) {
      if (ai == 1 && !hiv) break;
      __syncthreads();
#pragma unroll
      for (int bj = 0; bj < 2; ++bj)
#pragma unroll
        for (int m = 0; m < 4; ++m)
#pragma unroll
          for (int n = 0; n < 2; ++n)
#pragma unroll
            for (int r = 0; r < 4; ++r) {
              const int row = wr * 64 + m * 16 + fq * 4 + r, col = bj * 128 + wc * 32 + n * 16 + fr;
              T[row * 256 + (col ^ ((fq & 1) << 4))] = acc[ai][bj][m][n][r];
            }
      __syncthreads();
      if constexpr (!PAIR) {
#pragma unroll 4
        for (int i = 0; i < 16; ++i) {
          const int row = wid + 8 * i;
          const float4 v = *(const float4*)(T + row * 256 + ((lane * 4) ^ (((row >> 2) & 1) << 4)));
          epi(brow + ai * 128 + row, bcol + lane * 4, v, v);
        }
      } else {
#pragma unroll 4
        for (int i = 0; i < 8; ++i) {
          const int row = wid * 2 + (lane >> 5) + 16 * i;
          const int j = lane & 31, blk = j >> 2, q = j & 3;
          const int sw = ((row >> 2) & 1) << 4;
          const float4 vg = *(const float4*)(T + row * 256 + ((blk * 32 + q * 4) ^ sw));
          const float4 vu = *(const float4*)(T + row * 256 + ((blk * 32 + 16 + q * 4) ^ sw));
          epi(brow + ai * 128 + row, (bcol >> 1) + blk * 16 + q * 4, vg, vu);
        }
      }
    }
  }
#undef G8_SA
#undef G8_SB
#undef G8_STAGE_X
#undef G8_STAGE_A
#undef G8_STAGE_B
#undef G8_STAGE_Bt
#undef G8_STAGE
#undef G8_LDA
#undef G8_LDB
#undef G8_MMA
#undef G8_WAIT_V
#undef G8_WAIT_L
#undef G8_BAR
#undef G8_SCHED
}
__device__ __forceinline__ void g8_tile(int t, int nM, int nN, int& pm, int& pn) {
  const int nig = 8 * nN, gid = t / nig, fm = gid * 8, gsz = min(nM - fm, 8);
  pm = fm + ((t % nig) % gsz); pn = (t % nig) / gsz;
}

__device__ __forceinline__ void phase_prologue(PR p, unsigned char* smem) {
  const int tid = otid();
  float* fs = (float*)smem;
  {
    const int j = tid & 255, qh = tid >> 8;
    const float omega = exp2f(-(float)j * (13.287712379549449f / 256.0f));
    for (int r0 = blockIdx.x; r0 < NROW; r0 += 4 * gridDim.x) {
      float va[4], vb[4];
#pragma unroll
      for (int u = 0; u < 4; ++u) {
        const int r = min(r0 + u * (int)gridDim.x, NROW - 1);
        const float* src = (r < NLAT) ? p.x + (size_t)r * DM : p.ctx + (size_t)(r - NLAT) * DM;
        va[u] = __builtin_nontemporal_load(src + tid);
        vb[u] = __builtin_nontemporal_load(src + 512 + tid);
      }
#pragma unroll
      for (int u = 0; u < 4; ++u) {
        const int r = r0 + u * (int)gridDim.x;
        if (r < NROW) {
          float a = va[u], b = vb[u];
          if (r < NLAT) {
            const int t = r & (SEQL - 1);
            const float a0 = (float)(t >> 6) * omega, a1 = (float)(t & 63) * omega;
            a += qh ? __cosf(a0) : __sinf(a0);
            b += qh ? __cosf(a1) : __sinf(a1);
          }
          p.X[(size_t)r * DM + tid] = f2bf(a);
          p.X[(size_t)r * DM + 512 + tid] = f2bf(b);
        }
      }
    }
  }
  for (int it = blockIdx.x; it < 192; it += gridDim.x) {
    const int l = it / 96, n0 = (it % 96) * 64;
    __syncthreads();
    for (int e = tid; e < 3 * DM; e += NTH) {
      const int j = e >> 10, k = e & 1023;
      const float cv = (j < 2) ? p.c[j * DM + k] : p.c_ctx[k];
      fs[e] = siluf_(cv);
    }
    __syncthreads();
    const int n4 = tid & 15, ks = tid >> 4;
    float4 a0 = make_float4(0.f, 0.f, 0.f, 0.f), a1 = a0, a2 = a0;
    const float* W = p.ada_w + (size_t)l * DM * 6144 + n0 + n4 * 4;
#pragma unroll 8
    for (int k = ks * 32; k < ks * 32 + 32; ++k) {
      const f32x4 wv_ = __builtin_nontemporal_load((const f32x4*)(W + (size_t)k * 6144));
      const float4 wv = make_float4(wv_[0], wv_[1], wv_[2], wv_[3]);
      const float c0 = fs[k], c1 = fs[1024 + k], c2 = fs[2048 + k];
      a0.x += c0 * wv.x; a0.y += c0 * wv.y; a0.z += c0 * wv.z; a0.w += c0 * wv.w;
      a1.x += c1 * wv.x; a1.y += c1 * wv.y; a1.z += c1 * wv.z; a1.w += c1 * wv.w;
      a2.x += c2 * wv.x; a2.y += c2 * wv.y; a2.z += c2 * wv.z; a2.w += c2 * wv.w;
    }
    float* red = fs + 3 * DM;
    *(float4*)(red + (ks * 3 + 0) * 64 + n4 * 4) = a0;
    *(float4*)(red + (ks * 3 + 1) * 64 + n4 * 4) = a1;
    *(float4*)(red + (ks * 3 + 2) * 64 + n4 * 4) = a2;
    __syncthreads();
    if (tid < 192) {
      const int j = tid >> 6, nn = tid & 63;
      float s = p.ada_b[l * 6144 + n0 + nn];
#pragma unroll
      for (int q = 0; q < 32; ++q) s += red[(q * 3 + j) * 64 + nn];
      p.MOD[(l * 3 + j) * 6144 + n0 + nn] = s;
    }
  }
  if (blockIdx.x == 0) {
    if (tid < 256) {
      const float a = p.hg_lb_logits[tid], b = p.hg_lb_logits[256 + tid];
      const float m = fmaxf(a, b);
      const float ea = expf(a - m), eb = expf(b - m);
      p.LBv[tid] = 0.f;
      p.LBv[256 + tid] = eb / (ea + eb);
    }
    p.CNT[tid] = 0;
    if (tid < 8) p.WQ[tid] = 0;
  }
  {
    const int lane = tid & 63, w = tid >> 6;
    float* zs = fs;
    const int rot = ((int)blockIdx.x + (int)gridDim.x - (192 % (int)gridDim.x)) % (int)gridDim.x;
    for (int pass = 0; pass < 2; ++pass)
    for (int it = pass ? 256 + rot : (int)blockIdx.x; it < (pass ? 272 : 256); it += gridDim.x) {
      const bool isc = it >= 256;
      const int l = isc ? 0 : it >> 7;
      const int nlg = isc ? 1 : 4;
      const int lag0 = isc ? (it - 256) * 16 : (it & 127) * 64;
      const int L = isc ? 256 : 8192;
      __syncthreads();
      for (int q = 0; q < 2 * nlg; ++q) {
        const int i = lag0 + w * 2 * nlg + q;
        const float tt = (float)i / (float)(L - 1);
        const float wv = 6.283185307179586f * (float)i / (float)L;
        float feat = 0.f;
        if (lane == 0) feat = tt;
        else if (lane < 33) {
          const int jb = (lane - 1) & 15;
          const float band = 1e-4f + (float)jb * ((15.0f - 1e-4f) / 15.0f);
          const float ang = band * wv;
          feat = (lane <= 16) ? cosf(ang) : -sinf(ang);
        }
        float a = p.hy_b1[l * 64 + lane];
        for (int j = 0; j < 33; ++j) a += shu(feat, j) * p.hy_w1[(l * 33 + j) * 64 + lane];
        const float z1 = sinf(p.hy_freq[(l * 2 + 0) * 64 + lane] * a);
        float a2 = p.hy_b2[l * 64 + lane];
        for (int j = 0; j < 64; ++j) a2 += shu(z1, j) * p.hy_w2[(l * 64 + j) * 64 + lane];
        zs[(w * 2 * nlg + q) * 65 + lane] = sinf(p.hy_freq[(l * 2 + 1) * 64 + lane] * a2);
      }
      __syncthreads();
      const float* w3 = p.hy_w3 + (size_t)l * 64 * 1024;
      const int fr = lane & 15, fk = lane >> 4;
#pragma unroll 1
      for (int nh = 0; nh < 2; ++nh) {
        f32x4 c00 = {0.f, 0.f, 0.f, 0.f}, c01 = c00, c02 = c00, c03 = c00, c10 = c00, c11 = c00, c12 = c00, c13 = c00,
              c20 = c00, c21 = c00, c22 = c00, c23 = c00, c30 = c00, c31 = c00, c32 = c00, c33 = c00;
        const float* wb = w3 + (size_t)fk * 1024 + w * 128 + nh * 64 + fr;
        const float* za = zs + fr * 65 + fk;
#pragma unroll 4
        for (int ks = 0; ks < 16; ++ks) {
          const float b0 = wb[(size_t)ks * 4096], b1 = wb[(size_t)ks * 4096 + 16], b2 = wb[(size_t)ks * 4096 + 32], b3 = wb[(size_t)ks * 4096 + 48];
          const float a0 = za[ks * 4], a1 = za[16 * 65 + ks * 4], a2 = za[32 * 65 + ks * 4], a3 = za[48 * 65 + ks * 4];
#define HF_MMA(C, A_, B_) C = __builtin_amdgcn_mfma_f32_16x16x4f32(A_, B_, C, 0, 0, 0)
          HF_MMA(c00, a0, b0); HF_MMA(c01, a0, b1); HF_MMA(c02, a0, b2); HF_MMA(c03, a0, b3);
          HF_MMA(c10, a1, b0); HF_MMA(c11, a1, b1); HF_MMA(c12, a1, b2); HF_MMA(c13, a1, b3);
          HF_MMA(c20, a2, b0); HF_MMA(c21, a2, b1); HF_MMA(c22, a2, b2); HF_MMA(c23, a2, b3);
          HF_MMA(c30, a3, b0); HF_MMA(c31, a3, b1); HF_MMA(c32, a3, b2); HF_MMA(c33, a3, b3);
#undef HF_MMA
        }
#define HF_ST(C, LB, NB) if ((LB) < nlg) { const int n_ = w * 128 + nh * 64 + (NB) * 16 + fr; const int lg_ = lag0 + (LB) * 16 + fk * 4; \
          float* o_ = isc ? p.HFTC + (size_t)n_ * 256 + lg_ : p.HFT + ((size_t)l * 1024 + n_) * 8192 + lg_; \
          *(float4*)o_ = make_float4(C[0], C[1], C[2], C[3]); }
        HF_ST(c00, 0, 0) HF_ST(c01, 0, 1) HF_ST(c02, 0, 2) HF_ST(c03, 0, 3)
        HF_ST(c10, 1, 0) HF_ST(c11, 1, 1) HF_ST(c12, 1, 2) HF_ST(c13, 1, 3)
        HF_ST(c20, 2, 0) HF_ST(c21, 2, 1) HF_ST(c22, 2, 2) HF_ST(c23, 2, 3)
        HF_ST(c30, 3, 0) HF_ST(c31, 3, 1) HF_ST(c32, 3, 2) HF_ST(c33, 3, 3)
#undef HF_ST
      }
    }
  }
  {
    const int gt = blockIdx.x * NTH + tid, ntot = gridDim.x * NTH;
    const int n0c = 2 * 4096 * 128, n1c = 2 * 1024 * 128, n2c = 2 * 512 * 128, n3c = 2 * 1024 * 32, n4c = 2 * 256 * 384;
    for (int e = gt; e < n0c + n1c + n2c + n3c + n4c; e += ntot) {
      const float* src; u16* dst; int n, kc, K, lds_, col; int lo = 0; int kcs;
      bool zero = false;
      if (e < n0c) { const int l = e / (4096 * 128), q = e % (4096 * 128); n = q % 4096; kc = q / 4096; K = 1024; lds_ = DIN; col = (n < DIN) ? n : 0; zero = n >= DIN;
        src = p.w_in + (size_t)l * DM * DIN; dst = p.WinT + (size_t)l * 4096 * 1024; }
      else if (e < n0c + n1c) { const int q0 = e - n0c; const int l = q0 / (1024 * 128), q = q0 % (1024 * 128); n = q % 1024; kc = q / 1024; K = 1024; lds_ = DM; col = n;
        src = p.w_out + (size_t)l * DM * DM; dst = p.WoutT + (size_t)l * 1024 * 1024; }
      else if (e < n0c + n1c + n2c) { const int q0 = e - n0c - n1c; const int l = q0 / (512 * 128), q = q0 % (512 * 128); n = q % 512; kc = q / 512; K = 1024; lds_ = 512;
        col = ((n & 31) < 16) ? ((n >> 5) * 16 + (n & 15)) : (256 + (n >> 5) * 16 + (n & 15));
        src = p.sh_w_gu + (size_t)l * DM * 512; dst = p.ShGuT + (size_t)l * 512 * 1024; }
      else if (e < n0c + n1c + n2c + n3c) { const int q0 = e - n0c - n1c - n2c; const int l = q0 / (1024 * 32), q = q0 % (1024 * 32); n = q % 1024; kc = q / 1024; K = 256; lds_ = DM; col = n;
        src = p.sh_w_down + (size_t)l * 256 * DM; dst = p.ShDnT + (size_t)l * 1024 * 256; }
      else { const int q0 = e - n0c - n1c - n2c - n3c; const int l = q0 / (256 * 384), q = q0 % (256 * 384); n = q % 256; kc = q / 256; K = 3072; lds_ = 256; col = n;
        lo = (kc >= 128 && kc < 256) ? 1 : 0;
        src = p.router_w + (size_t)l * DM * 256; dst = p.RWT + (size_t)l * 256 * 3072; }
      kcs = (K == 3072) ? (kc & 127) : kc;
      const float* sp = src + (size_t)(kcs * 8) * lds_ + col;
#define NTF(P_) __builtin_nontemporal_load(P_)
      float f0 = NTF(sp), f1 = NTF(sp + (size_t)lds_), f2 = NTF(sp + (size_t)2 * lds_), f3 = NTF(sp + (size_t)3 * lds_);
      float f4 = NTF(sp + (size_t)4 * lds_), f5 = NTF(sp + (size_t)5 * lds_), f6 = NTF(sp + (size_t)6 * lds_), f7 = NTF(sp + (size_t)7 * lds_);
#undef NTF
      if (lo) {
        f0 -= bf2f(f2bf(f0)); f1 -= bf2f(f2bf(f1)); f2 -= bf2f(f2bf(f2)); f3 -= bf2f(f2bf(f3));
        f4 -= bf2f(f2bf(f4)); f5 -= bf2f(f2bf(f5)); f6 -= bf2f(f2bf(f6)); f7 -= bf2f(f2bf(f7));
      }
      uint4 o;
      o.x = pk2bf(f0, f1);
      o.y = pk2bf(f2, f3);
      o.z = pk2bf(f4, f5);
      o.w = pk2bf(f6, f7);
      if (zero) o = make_uint4(0u, 0u, 0u, 0u);
      *(uint4*)(dst + (size_t)n * K + kc * 8) = o;
    }
  }
}

__device__ __forceinline__ float4 ldx4(const u16* q) {
  const uint2 t = *(const uint2*)q;
  return make_float4(bf2f((u16)(t.x & 0xFFFF)), bf2f((u16)(t.x >> 16)), bf2f((u16)(t.y & 0xFFFF)), bf2f((u16)(t.y >> 16)));
}
__device__ __forceinline__ void stx4(u16* q, const float4& v) { *(uint2*)q = make_uint2(pk2bf(v.x, v.y), pk2bf(v.z, v.w)); }
__device__ __forceinline__ int mod_index(int r) { return r < NLAT ? (r >> 13) : 2; }

__device__ __forceinline__ void phase_norm1(PR p, int l) {
  const int tid_ = otid();
  const int lane = tid_ & 63;
  const int gw = blockIdx.x * 8 + (tid_ >> 6), nw = gridDim.x * 8;
  const float* g = p.norm_g + (l * 4 + 0) * DM;
  for (int r = gw; r < NROW; r += nw) {
    const float* mod = p.MOD + (l * 3 + mod_index(r)) * 6144;
    float4 xv[4];
    float ss = 0.f;
#pragma unroll
    for (int q = 0; q < 4; ++q) {
      xv[q] = ldx4(p.X + (size_t)r * DM + q * 256 + lane * 4);
      ss += xv[q].x * xv[q].x + xv[q].y * xv[q].y + xv[q].z * xv[q].z + xv[q].w * xv[q].w;
    }
    ss = wave_sum(ss);
    const float rs = rsqrtf(ss * (1.f / DM) + EPSV);
#pragma unroll
    for (int q = 0; q < 4; ++q) {
      const int e = q * 256 + lane * 4;
      const float4 gv = *(const float4*)(g + e);
      const float4 sh = *(const float4*)(mod + e);
      const float4 sc = *(const float4*)(mod + 1024 + e);
      uint2 o;
      o.x = (uint32_t)f2bf(xv[q].x * rs * gv.x * (1.f + sc.x) + sh.x) | ((uint32_t)f2bf(xv[q].y * rs * gv.y * (1.f + sc.y) + sh.y) << 16);
      o.y = (uint32_t)f2bf(xv[q].z * rs * gv.z * (1.f + sc.z) + sh.z) | ((uint32_t)f2bf(xv[q].w * rs * gv.w * (1.f + sc.w) + sh.w) << 16);
      *(uint2*)(p.HN + (size_t)r * DM + e) = o;
    }
  }
}

__device__ __forceinline__ void phase_inproj(PR p, int l, unsigned char* smem) {
  const int NFULL = 66 * 15, NTAIL = 66;
  u16* P_ = p.P; u16* PT_ = p.PT;
  const u16* Wt = p.WinT + (size_t)l * 4096 * 1024;
  TileIter ti;
  for (int it = ti.next(NFULL + NTAIL); it >= 0; it = ti.next(NFULL + NTAIL)) {
    if (it < NFULL) {
      int pm, pn;
      g8_tile(it, 66, 15, pm, pn);
      if (pn < 3)
        gemm256<false, false, 0>(p.HN, p.HN, 1 << 30, DM, Wt, DM, pm * 256, pn * 256, smem,
                       [&](int row0, int col, const f32x4& v, const f32x4&) {
                         *(uint2*)(PT_ + (size_t)col * NROW + row0) = make_uint2(pk2bf(v[0], v[1]), pk2bf(v[2], v[3]));
                       });
      else
        gemm256<false, false, 1>(p.HN, p.HN, 1 << 30, DM, Wt, DM, pm * 256, pn * 256, smem,
                       [&](int row, int col, const float4& v, const float4&) { *(uint2*)(P_ + (size_t)row * DIN + col) = make_uint2(pk2bf(v.x, v.y), pk2bf(v.z, v.w)); });
    } else {
      const int pm = it - NFULL;
      gemm256<false, false, 1>(p.HN, p.HN, 1 << 30, DM, Wt, DM, pm * 256, 3840, smem,
                     [&](int row, int col, const float4& v, const float4&) { if (col < DIN) *(uint2*)(P_ + (size_t)row * DIN + col) = make_uint2(pk2bf(v.x, v.y), pk2bf(v.z, v.w)); },
                     nullptr, 256, 48);
    }
  }
}

__device__ __forceinline__ int lat_row(int b, int t) { return b * SEQL + t; }
__device__ __forceinline__ int ctx_row(int b, int t) { return NLAT + b * CTXL + t; }

__device__ __forceinline__ float hy_sconv(PR p, int l, int rowbase, int t, int L, int ch) {
  const float* cw = p.hy_conv_w + (size_t)l * 3 * 768;
  float a = p.hy_conv_b[l * 768 + ch];
  const u16* Pc = p.PT + (size_t)ch * NROW + rowbase + t;
  if (t > 0) a += bf2f(Pc[-1]) * cw[ch];
  a += bf2f(Pc[0]) * cw[768 + ch];
  if (t < L - 1) a += bf2f(Pc[1]) * cw[2 * 768 + ch];
  return a;
}

#define HY_MIN_DECAY (-3.0701134573253944f)
#define HY_MAX_DECAY (-15.350567286626972f)

__device__ __forceinline__ float2 cmul(float2 a, float2 b) { return make_float2(a.x * b.x - a.y * b.y, a.x * b.y + a.y * b.x); }
__device__ __forceinline__ float2 cmulc(float2 a, float2 b) { return make_float2(a.x * b.x + a.y * b.y, a.y * b.x - a.x * b.y); }

template <bool INV, int S, bool PRUNE>
__device__ __forceinline__ void fft16k_stage(float2* X, const float2* twh, const float2* twl, int tid) {
  constexpr int Lq = 4096 >> (2 * S);
  constexpr int tsh = 2 * S;
#pragma unroll
  for (int g = 0; g < 4; ++g) {
    float2 a0[2], a1[2], a2[2], a3[2], w1[2];
#pragma unroll
    for (int u = 0; u < 2; ++u) {
      const int bidx = tid + NTH * (g * 2 + u);
      const int j = bidx & (Lq - 1);
      const float2* ptr = X + ((bidx - j) << 2) + j;
      a0[u] = ptr[0]; a1[u] = ptr[Lq];
      if (PRUNE && !INV && S == 0) { a2[u] = make_float2(0.f, 0.f); a3[u] = make_float2(0.f, 0.f); }
      else { a2[u] = ptr[2 * Lq]; a3[u] = ptr[3 * Lq]; }
      const int e1 = j << tsh;
      w1[u] = cmul(twh[e1 >> 7], twl[e1 & 127]);
    }
#pragma unroll
    for (int u = 0; u < 2; ++u) {
      const int bidx = tid + NTH * (g * 2 + u);
      const int j = bidx & (Lq - 1);
      float2* ptr = X + ((bidx - j) << 2) + j;
      const float2 w2 = cmul(w1[u], w1[u]), w3 = cmul(w2, w1[u]);
      if (!INV) {
        const float2 b0 = make_float2(a0[u].x + a2[u].x, a0[u].y + a2[u].y), b1 = make_float2(a0[u].x - a2[u].x, a0[u].y - a2[u].y);
        const float2 b2 = make_float2(a1[u].x + a3[u].x, a1[u].y + a3[u].y), d = make_float2(a1[u].x - a3[u].x, a1[u].y - a3[u].y);
        const float2 b3 = make_float2(d.y, -d.x);
        ptr[0] = make_float2(b0.x + b2.x, b0.y + b2.y);
        ptr[Lq] = cmul(make_float2(b1.x + b3.x, b1.y + b3.y), w1[u]);
        ptr[2 * Lq] = cmul(make_float2(b0.x - b2.x, b0.y - b2.y), w2);
        ptr[3 * Lq] = cmul(make_float2(b1.x - b3.x, b1.y - b3.y), w3);
      } else {
        const float2 y0 = a0[u], y1 = cmulc(a1[u], w1[u]), y2 = cmulc(a2[u], w2), y3 = cmulc(a3[u], w3);
        const float2 b0 = make_float2(y0.x + y2.x, y0.y + y2.y), b1 = make_float2(y0.x - y2.x, y0.y - y2.y);
        const float2 b2 = make_float2(y1.x + y3.x, y1.y + y3.y), d = make_float2(y1.x - y3.x, y1.y - y3.y);
        const float2 b3 = make_float2(-d.y, d.x);
        ptr[0] = make_float2(b0.x + b2.x, b0.y + b2.y);
        ptr[Lq] = make_float2(b1.x + b3.x, b1.y + b3.y);
        ptr[2 * Lq] = make_float2(b0.x - b2.x, b0.y - b2.y);
        ptr[3 * Lq] = make_float2(b1.x - b3.x, b1.y - b3.y);
      }
    }
  }
  __syncthreads();
}
template <bool INV, bool PRUNE>
__device__ __forceinline__ void fft16k(float2* X, const float2* twh, const float2* twl, int tid) {
  if (!INV) {
    fft16k_stage<false, 0, PRUNE>(X, twh, twl, tid); fft16k_stage<false, 1, PRUNE>(X, twh, twl, tid); fft16k_stage<false, 2, PRUNE>(X, twh, twl, tid);
    fft16k_stage<false, 3, PRUNE>(X, twh, twl, tid); fft16k_stage<false, 4, PRUNE>(X, twh, twl, tid); fft16k_stage<false, 5, PRUNE>(X, twh, twl, tid);
    fft16k_stage<false, 6, PRUNE>(X, twh, twl, tid);
  } else {
    fft16k_stage<true, 6, PRUNE>(X, twh, twl, tid); fft16k_stage<true, 5, PRUNE>(X, twh, twl, tid); fft16k_stage<true, 4, PRUNE>(X, twh, twl, tid);
    fft16k_stage<true, 3, PRUNE>(X, twh, twl, tid); fft16k_stage<true, 2, PRUNE>(X, twh, twl, tid); fft16k_stage<true, 1, PRUNE>(X, twh, twl, tid);
    fft16k_stage<true, 0, PRUNE>(X, twh, twl, tid);
  }
}

__device__ void hyena_latent(PR p, int l, int c, unsigned char* smem) {
  float2* X = (float2*)smem;
  float2* twh = X + 16384;
  float2* twl = twh + 128;
  float* red = (float*)(twl + 128);
  const int tid = otid();
  float zf = 0.f;
  asm volatile("" : "+v"(zf));
  const float delta = fabsf(HY_MIN_DECAY + (float)c * ((HY_MAX_DECAY - HY_MIN_DECAY) / 255.0f));
  __syncthreads();
  if (tid < 128) {
    float sn, cs;
    sincospif((float)tid / 64.0f, &sn, &cs);
    twh[tid] = make_float2(cs, -sn);
  } else if (tid < 256) {
    float sn, cs;
    sincospif((float)(tid - 128) / 8192.0f, &sn, &cs);
    twl[tid - 128] = make_float2(cs, -sn);
  }
  f32x16v g0, g1, g2, g3;
  {
    const float* hf0p = p.HFT + ((size_t)l * 1024 + 0 * 256 + c) * 8192 + tid;
    const float* hb0p = p.HFT + ((size_t)l * 1024 + 1 * 256 + c) * 8192 + tid;
    const float* hf1p = p.HFT + ((size_t)l * 1024 + 2 * 256 + c) * 8192 + tid;
    const float* hb1p = p.HFT + ((size_t)l * 1024 + 3 * 256 + c) * 8192 + tid;
#pragma unroll
    for (int k = 0; k < 16; ++k) {
      g0[k] = __builtin_nontemporal_load(hf0p + NTH * k); g1[k] = __builtin_nontemporal_load(hb0p + NTH * k);
      g2[k] = __builtin_nontemporal_load(hf1p + NTH * k); g3[k] = __builtin_nontemporal_load(hb1p + NTH * k);
    }
  }
  f32x16v ua, ub, xa, xb;
#pragma unroll
  for (int i = 0; i < 16; ++i) {
    const int t = tid + NTH * i;
    ua[i] = hy_sconv(p, l, 0, t, SEQL, c); ub[i] = hy_sconv(p, l, SEQL, t, SEQL, c);
    xa[i] = hy_sconv(p, l, 0, t, SEQL, 256 + c); xb[i] = hy_sconv(p, l, SEQL, t, SEQL, 256 + c);
  }
  {
    __syncthreads();
    float l1a = 0.f, l1b = 0.f;
#pragma unroll
    for (int k = 0; k < 16; ++k) {
      const int i = tid + NTH * k;
      const float win = expf(-((float)i / 8191.0f) * delta);
      const float hf0 = g0[k] * win, hb0 = g1[k] * win, hf1 = g2[k] * win, hb1 = g3[k] * win;
      X[i] = make_float2(hf0, hf1);
      l1a += fabsf(hf0); l1b += fabsf(hf1);
      if (i >= 1) { X[16384 - i] = make_float2(hb0, hb1); l1a += fabsf(hb0); l1b += fabsf(hb1); }
    }
    if (tid == 0) X[8192] = make_float2(zf, zf);
    {
      l1a = wave_sum(l1a); l1b = wave_sum(l1b);
      __syncthreads();
      if ((tid & 63) == 0) { red[tid >> 6] = l1a; red[8 + (tid >> 6)] = l1b; }
      __syncthreads();
      float sa = 0.f, sb = 0.f;
#pragma unroll
      for (int i = 0; i < 8; ++i) { sa += red[i]; sb += red[8 + i]; }
      l1a = sa; l1b = sb;
    }
    const float scl0 = 0.5f / (l1a * 16384.0f), scl1 = 0.5f / (l1b * 16384.0f);
    fft16k<false, false>(X, twh, twl, tid);
    uint32_t* hs0 = p.HS + ((size_t)c * 2 + 0) * 16384;
    uint32_t* hs1 = p.HS + ((size_t)c * 2 + 1) * 16384;
#pragma unroll 4
    for (int idx = tid; idx < 16384; idx += NTH) {
      unsigned v = __brev((unsigned)idx) >> 18;
      v = ((v & 0x1555u) << 1) | ((v >> 1) & 0x1555u);
      const unsigned kq = (16384u - v) & 16383u;
      unsigned w_ = __brev(kq) >> 18;
      w_ = ((w_ & 0x1555u) << 1) | ((w_ >> 1) & 0x1555u);
      const float2 a_ = X[idx], b_ = X[w_];
      hs0[idx] = pk2bf((a_.x + b_.x) * scl0, (a_.y - b_.y) * scl0);
      hs1[idx] = pk2bf((a_.y + b_.y) * scl1, (b_.x - a_.x) * scl1);
    }
  }
  __syncthreads();
#pragma unroll
  for (int i = 0; i < 16; ++i) {
    const int t = tid + NTH * i;
    X[t] = make_float2(ua[i], ub[i]);
  }
  __syncthreads();
  u32x16v hq0a, hq0b;
  {
    const uint32_t* hs = p.HS + ((size_t)c * 2 + 0) * 16384 + tid;
#pragma unroll
    for (int i = 0; i < 16; ++i) { hq0a[i] = __builtin_nontemporal_load(hs + NTH * i); hq0b[i] = __builtin_nontemporal_load(hs + NTH * (16 + i)); }
  }
  fft16k<false, true>(X, twh, twl, tid);
#pragma unroll
  for (int i = 0; i < 16; ++i) {
    const int ia = tid + NTH * i, ib = tid + NTH * (16 + i);
    X[ia] = cmul(X[ia], make_float2(bf2f((u16)(hq0a[i] & 0xFFFF)), bf2f((u16)(hq0a[i] >> 16))));
    X[ib] = cmul(X[ib], make_float2(bf2f((u16)(hq0b[i] & 0xFFFF)), bf2f((u16)(hq0b[i] >> 16))));
  }
  __syncthreads();
  fft16k<true, false>(X, twh, twl, tid);
  {
    const float bias0 = p.hy_bias[(l * 2 + 0) * 256 + c];
#pragma unroll
    for (int i = 0; i < 16; ++i) {
      const int t = tid + NTH * i;
      const float2 y = X[t];
      const float z0 = xa[i] * (y.x + ua[i] * bias0);
      const float z1 = xb[i] * (y.y + ub[i] * bias0);
      ua[i] = z0; ub[i] = z1;
      X[t] = make_float2(z0, z1);
    }
#pragma unroll
    for (int i = 0; i < 16; ++i) {
      const int t = tid + NTH * i;
      xa[i] = hy_sconv(p, l, 0, t, SEQL, 512 + c); xb[i] = hy_sconv(p, l, SEQL, t, SEQL, 512 + c);
    }
  }
  __syncthreads();
  u32x16v hq1a, hq1b;
  {
    const uint32_t* hs = p.HS + ((size_t)c * 2 + 1) * 16384 + tid;
#pragma unroll
    for (int i = 0; i < 16; ++i) { hq1a[i] = __builtin_nontemporal_load(hs + NTH * i); hq1b[i] = __builtin_nontemporal_load(hs + NTH * (16 + i)); }
  }
  fft16k<false, true>(X, twh, twl, tid);
#pragma unroll
  for (int i = 0; i < 16; ++i) {
    const int ia = tid + NTH * i, ib = tid + NTH * (16 + i);
    X[ia] = cmul(X[ia], make_float2(bf2f((u16)(hq1a[i] & 0xFFFF)), bf2f((u16)(hq1a[i] >> 16))));
    X[ib] = cmul(X[ib], make_float2(bf2f((u16)(hq1b[i] & 0xFFFF)), bf2f((u16)(hq1b[i] >> 16))));
  }
  __syncthreads();
  fft16k<true, false>(X, twh, twl, tid);
  {
    const float bias1 = p.hy_bias[(l * 2 + 1) * 256 + c];
#pragma unroll
    for (int i = 0; i < 16; ++i) {
      const int t = tid + NTH * i;
      const float2 y = X[t];
      p.HYRAW[(size_t)c * NROW + lat_row(0, t)] = xa[i] * (y.x + ua[i] * bias1);
      p.HYRAW[(size_t)c * NROW + lat_row(1, t)] = xb[i] * (y.y + ub[i] * bias1);
    }
  }
  __syncthreads();
}

__device__ void hyena_ctx(PR p, int l, int c, unsigned char* smem) {
  float* G = (float*)smem;
  float* U = G + 512;
  float* red = U + 512;
  const int tid = otid();
  const float delta = fabsf(HY_MIN_DECAY + (float)c * ((HY_MAX_DECAY - HY_MIN_DECAY) / 255.0f));
  const int b = tid >> 8, t = tid & 255;
  float zr = 0.f;
  for (int order = 0; order < 2; ++order) {
    __syncthreads();
    float l1 = 0.f;
    if (tid < 256) {
      const int i = tid;
      const float win = expf(-((float)i / 255.0f) * delta);
      const float hf = p.HFTC[(size_t)((order * 2 + 0) * 256 + c) * 256 + i] * win;
      const float hb = p.HFTC[(size_t)((order * 2 + 1) * 256 + c) * 256 + i] * win;
      G[256 + i] = hf;
      l1 += fabsf(hf);
      if (i >= 1) { G[256 - i] = hb; l1 += fabsf(hb); }
      if (i == 0) G[0] = 0.f;
    }
    if (order == 0) U[tid] = hy_sconv(p, l, NLAT + b * CTXL, t, CTXL, c);
    else U[tid] = zr;
    l1 = block_sum(l1, red);
    const float inv_l1 = 1.0f / l1;
    float acc = 0.f;
#pragma unroll 4
    for (int s2 = 0; s2 < 256; ++s2) acc += G[256 + t - s2] * U[b * 256 + s2];
    const float y = acc * inv_l1 + U[tid] * p.hy_bias[(l * 2 + order) * 256 + c];
    if (order == 0) zr = hy_sconv(p, l, NLAT + b * CTXL, t, CTXL, 256 + c) * y;
    else p.HYRAW[(size_t)c * NROW + ctx_row(b, t)] = hy_sconv(p, l, NLAT + b * CTXL, t, CTXL, 512 + c) * y;
  }
  __syncthreads();
}

struct MixLds {
  u16 Qt[64 * 72];
  u16 Qi[64 * 72];
  u16 Ki[160 * 72];
  u16 KT[64 * 72];
  u16 VT[64 * 72];
  u16 AT[64 * 72];
  u16 ST[64 * 72];
  float osum[64 * 64];
  float wt[8 * 64];
  float dnp[8 * 64];
  float nv[64];
  float den[64];
};
template <int MIX> struct MixCfg;
template <> struct MixCfg<0> { static constexpr int DK = 64; static constexpr bool HASN = false; };
template <> struct MixCfg<1> { static constexpr int DK = 32; static constexpr bool HASN = false; };
template <> struct MixCfg<2> { static constexpr int DK = 64; static constexpr bool HASN = true; };

__device__ __forceinline__ u16* mix_sb(PR p, int mix) { return mix == 0 ? p.SBHG : (mix == 1 ? p.SBGL : p.SBML); }
__device__ __forceinline__ float* mix_dc(PR p, int mix) { return mix == 0 ? p.DCHG : (mix == 1 ? p.DCGL : p.DCML); }

struct MixRaw { f32x8v v, x0, x1, x2; f32x16v rq, rk; };

template <int MIX, bool NEEDQ>
__device__ __forceinline__ void mix_fetch(PR p, int l, int b, int h, int dir, int cc, int tid, MixRaw& r) {
  constexpr int DK = MixCfg<MIX>::DK;
  const int lane = tid & 63, w = tid >> 6;
  const int seg = cc < 4 ? 0 : 1;
  const int kc = seg ? cc - 4 : cc;
  const int L = seg ? SEQL : CTXL;
  const int rowbase = seg ? b * SEQL : NLAT + b * CTXL;
  if (MIX == 2) {
    const int tfirst = dir ? (L - 1 - (kc * 64 + w * 8)) : (kc * 64 + w * 8);
#pragma unroll
    for (int j = 0; j < 10; ++j) {
      const int tr = dir ? (tfirst + 1 - j) : (tfirst - 1 + j);
      const bool ok = (tr >= 0) && (tr < L);
      const u16* Prr = p.P + (size_t)(rowbase + (ok ? tr : tfirst)) * DIN + 2848 + h * 64 + lane;
      const float a_ = NEEDQ ? bf2f(Prr[0]) : 0.f, b_ = bf2f(Prr[256]);
      r.rq[j] = ok ? a_ : 0.f; r.rk[j] = ok ? b_ : 0.f;
    }
  }
#pragma unroll
  for (int i = 0; i < 8; ++i) {
    const int tau = kc * 64 + w * 8 + i;
    const int t = dir ? (L - 1 - tau) : tau;
    const u16* Pr = p.P + (size_t)(rowbase + t) * DIN;
    if (MIX == 0) {
      r.v[i] = bf2f(Pr[1024 + h * 64 + lane]);
      r.x0[i] = bf2f(Pr[(dir ? 1536 : 1280) + h * 64 + lane]);
      if (NEEDQ) r.x1[i] = bf2f(Pr[768 + h * 64 + lane]);
    } else if (MIX == 1) {
      r.v[i] = bf2f(Pr[2304 + h * 64 + lane]);
      r.x0[i] = bf2f(Pr[2176 + h * 32 + (lane & 31)]);
      if (NEEDQ) r.x1[i] = bf2f(Pr[2048 + h * 32 + (lane & 31)]);
      r.x2[i] = bf2f(Pr[2560 + dir * 16 + (lane & 15)]);
    } else {
      r.v[i] = bf2f(Pr[3360 + h * 64 + lane]);
      r.x0[i] = bf2f(Pr[3616 + (dir ? 8 : 0) + h]);
      r.x1[i] = bf2f(Pr[3616 + (dir ? 12 : 4) + h]);
    }
  }
}

struct MixPar { f32x16v au; float gab, lb, ck0, ck1, ck2, ckb, cq0, cq1, cq2, cqb, igb, fgb; };
template <int MIX, bool NEEDQ>
__device__ __forceinline__ void mix_params(PR p, int l, int h, int dir, int tid, MixPar& mp) {
  const int lane = tid & 63;
  if (MIX == 1) {
    const int d = lane & 31;
#pragma unroll
    for (int q_ = 0; q_ < 16; ++q_) mp.au[q_] = p.gla_a_up[(size_t)(l * 2 + dir) * 16 * 128 + q_ * 128 + h * 32 + d];
    mp.gab = p.gla_a_b[(l * 2 + dir) * 128 + h * 32 + d];
  } else if (MIX == 0) {
    mp.lb = p.LBv[l * 256 + h * 64 + lane];
  } else {
    const int chq = h * 64 + lane, chk = 256 + h * 64 + lane;
    const float* cw = p.ml_conv_w + (size_t)l * 3 * 512;
    mp.ck0 = cw[chk]; mp.ck1 = cw[512 + chk]; mp.ck2 = cw[1024 + chk]; mp.ckb = p.ml_conv_b[l * 512 + chk];
    if (NEEDQ) { mp.cq0 = cw[chq]; mp.cq1 = cw[512 + chq]; mp.cq2 = cw[1024 + chq]; mp.cqb = p.ml_conv_b[l * 512 + chq]; }
    mp.igb = p.ml_gate_b[l * 16 + (dir ? 8 : 0) + h];
    mp.fgb = p.ml_gate_b[l * 16 + (dir ? 12 : 4) + h];
  }
}

template <int MIX, bool NEEDQ, int DIR>
__device__ __forceinline__ void mix_xform(PR p, int l, int h, int tid, const MixRaw& r, const MixPar& mp, MixLds* m, float (&qv)[8], float (&kv)[8],
                                          float (&bv)[8], float (&vv)[8], float& B1, float& B2, float& B3, float& bl) {
  constexpr int DK = MixCfg<MIX>::DK;
  constexpr int dir = DIR;
  const int lane = tid & 63, w = tid >> 6;
#pragma unroll
  for (int i = 0; i < 8; ++i) {
    vv[i] = r.v[i];
    float q = 0.f, k = 0.f, g = 0.f;
    if (MIX == 1) {
      float a = mp.gab;
#pragma unroll
      for (int q_ = 0; q_ < 16; ++q_) a += shu(r.x2[i], q_) * mp.au[q_];
      if (lane < DK) {
        if (NEEDQ) q = r.x1[i] * 0.17677669529663687f;
        k = r.x0[i];
        g = flogsigmoid(a) * (1.f / 16.f);
      }
    } else if (MIX == 0) {
      const float z = r.x0[i];
      const float lb = mp.lb;
      const float ls = flogsigmoid(z);
      k = (1.f - lb) * frcp(1.f + fexp(z));
      g = (lb > 0.f) ? __logf(lb + (1.f - lb) * fexp(ls)) : ls;
      if (NEEDQ) q = fsilu(r.x1[i]);
    } else {
      const float kp = dir ? r.rk[i + 2] : r.rk[i], kn = dir ? r.rk[i] : r.rk[i + 2];
      const float ck = mp.ckb + kp * mp.ck0 + r.rk[i + 1] * mp.ck1 + kn * mp.ck2;
      if (NEEDQ) {
        const float qp = dir ? r.rq[i + 2] : r.rq[i], qn = dir ? r.rq[i] : r.rq[i + 2];
        const float cq = mp.cqb + qp * mp.cq0 + r.rq[i + 1] * mp.cq1 + qn * mp.cq2;
        q = fsilu(cq);
      }
      const float ig = r.x0[i] + mp.igb;
      const float fg = r.x1[i] + mp.fgb;
      k = fsilu(ck) * 0.125f * fexp(ig);
      g = flogsigmoid(fg);
    }
    qv[i] = q; kv[i] = k; bv[i] = g;
  }
  float run = 0.f;
#pragma unroll
  for (int i = 0; i < 8; ++i) { run += bv[i]; bv[i] = run; }
  __syncthreads();
  m->wt[w * 64 + lane] = run;
  __syncthreads();
  float off = 0.f;
  B1 = 0.f; B2 = 0.f; B3 = 0.f; bl = 0.f;
#pragma unroll
  for (int ww = 0; ww < 8; ++ww) {
    const float x = m->wt[ww * 64 + lane];
    if (ww < w) off += x;
    if (ww < 2) B1 += x;
    if (ww < 4) B2 += x;
    if (ww < 6) B3 += x;
    bl += x;
  }
#pragma unroll
  for (int i = 0; i < 8; ++i) bv[i] += off;
}

__device__ __forceinline__ uint4 pack8(const float (&x)[8]) {
  uint4 r;
  r.x = pk2bf(x[0], x[1]);
  r.y = pk2bf(x[2], x[3]);
  r.z = pk2bf(x[4], x[5]);
  r.w = pk2bf(x[6], x[7]);
  return r;
}
__device__ __forceinline__ bf16x8 lds_frag(const u16* base, int row0, int k0, int lane) {
  return *(const bf16x8*)(base + (row0 + (lane & 15)) * 72 + k0 + (lane >> 4) * 8);
}

template <int MIX>
__device__ __forceinline__ void mix_summary(PR p, int l, int chain, int cc, const MixRaw& raw, const MixPar& mp, MixLds* m) {
  constexpr int DK = MixCfg<MIX>::DK;
  const int tid = otid();
  const int lane = tid & 63, w = tid >> 6;
  const int h = (chain >> 1) & 3;
  float qv[8], kv[8], bv[8], vv[8], B1, B2, B3, bl;
  if (chain & 1) mix_xform<MIX, false, 1>(p, l, h, tid, raw, mp, m, qv, kv, bv, vv, B1, B2, B3, bl);
  else mix_xform<MIX, false, 0>(p, l, h, tid, raw, mp, m, qv, kv, bv, vv, B1, B2, B3, bl);
  float ke[8];
  float dn = 0.f;
#pragma unroll
  for (int i = 0; i < 8; ++i) { ke[i] = kv[i] * fexp(bl - bv[i]); dn += ke[i]; }
  if (lane < DK) *(uint4*)(&m->KT[lane * 72 + w * 8]) = pack8(ke);
  *(uint4*)(&m->VT[lane * 72 + w * 8]) = pack8(vv);
  if (MIX == 2) m->dnp[w * 64 + lane] = dn;
  __syncthreads();
  u16* sb = mix_sb(p, MIX) + ((size_t)chain * NCH + cc) * (DK * 64);
  for (int tile = w; tile < (DK / 16) * 4; tile += 8) {
    const int db = tile >> 2, vb = tile & 3;
    f32x4 acc = {0.f, 0.f, 0.f, 0.f};
#pragma unroll
    for (int ks = 0; ks < 2; ++ks)
      acc = __builtin_amdgcn_mfma_f32_16x16x32_bf16(lds_frag(m->KT, db * 16, ks * 32, lane), lds_frag(m->VT, vb * 16, ks * 32, lane), acc, 0, 0, 0);
#pragma unroll
    for (int r = 0; r < 4; ++r) sb[(db * 16 + (lane >> 4) * 4 + r) * 64 + vb * 16 + (lane & 15)] = f2bf(acc[r]);
  }
  if (w == 0 && lane < DK) mix_dc(p, MIX)[((size_t)chain * NCH + cc) * DK + lane] = fexp(bl);
  if (MIX == 2 && w == 1) {
    float s2 = 0.f;
#pragma unroll
    for (int ww = 0; ww < 8; ++ww) s2 += m->dnp[ww * 64 + lane];
    p.NBML[((size_t)chain * NCH + cc) * 64 + lane] = s2;
  }
}

template <int MIX, int DIR>
__device__ __forceinline__ void mix_output_dir(PR p, int l, int b, int h, int tid, const MixRaw& raw, const float (&sv)[8], float nvp, MixLds* m) {
  constexpr int DK = MixCfg<MIX>::DK;
  constexpr bool HASN = MixCfg<MIX>::HASN;
  constexpr int dir = DIR;
  const int lane = tid & 63, w = tid >> 6;
  float qv[8], kv[8], bv[8], vv[8], B1, B2, B3, bl;
  MixPar mp;
  mix_params<MIX, true>(p, l, h, DIR, tid, mp);
  mix_xform<MIX, true, DIR>(p, l, h, tid, raw, mp, m, qv, kv, bv, vv, B1, B2, B3, bl);
  const int J = w >> 1;
  const float BJ = (J == 0) ? 0.f : (J == 1 ? B1 : (J == 2 ? B2 : B3));
  if (lane < DK) {
#pragma unroll
    for (int i = 0; i < 8; ++i) {
      const int tau = w * 8 + i;
      m->Qt[tau * 72 + lane] = f2bf(qv[i] * fexp(bv[i]));
      m->Qi[tau * 72 + lane] = f2bf(qv[i] * fexp(bv[i] - BJ));
      if (J <= 0) m->Ki[(0 + tau) * 72 + lane] = f2bf(kv[i] * fexp(fminf(0.f - bv[i], 80.f)));
      if (J <= 1) m->Ki[(16 + tau) * 72 + lane] = f2bf(kv[i] * fexp(fminf(B1 - bv[i], 80.f)));
      if (J <= 2) m->Ki[(48 + tau) * 72 + lane] = f2bf(kv[i] * fexp(fminf(B2 - bv[i], 80.f)));
      m->Ki[(96 + tau) * 72 + lane] = f2bf(kv[i] * fexp(fminf(B3 - bv[i], 80.f)));
    }
  }
  *(uint4*)(&m->VT[lane * 72 + w * 8]) = pack8(vv);
  {
    constexpr int DPW = DK / 8;
    if (DPW == 8) *(uint4*)(&m->ST[lane * 72 + w * 8]) = pack8(sv);
    else *(uint2*)(&m->ST[lane * 72 + w * 4]) = make_uint2(pk2bf(sv[0], sv[1]), pk2bf(sv[2], sv[3]));
    if (HASN && w == 0) m->nv[lane] = nvp;
  }
  __syncthreads();
#pragma unroll
  for (int q = 0; q < 2; ++q) {
    const int blk = w * 2 + q;
    const int I = blk >> 2, Jb = blk & 3;
    f32x4 acc = {0.f, 0.f, 0.f, 0.f};
    if (Jb <= I) {
      const int kioff = (I == 0) ? 0 : (I == 1 ? 16 : (I == 2 ? 48 : 96));
#pragma unroll
      for (int ks = 0; ks < DK / 32; ++ks)
        acc = __builtin_amdgcn_mfma_f32_16x16x32_bf16(lds_frag(m->Qi, I * 16, ks * 32, lane), lds_frag(m->Ki, kioff + Jb * 16, ks * 32, lane), acc, 0, 0, 0);
    }
#pragma unroll
    for (int r = 0; r < 4; ++r) {
      const int tl_ = (lane >> 4) * 4 + r, sl_ = lane & 15;
      float a = acc[r];
      if (Jb == I && sl_ > tl_) a = 0.f;
      m->AT[(I * 16 + tl_) * 72 + Jb * 16 + sl_] = f2bf(a);
    }
  }
  __syncthreads();
  if (HASN) {
#pragma unroll
    for (int i = 0; i < 8; ++i) {
      const int tau = w * 8 + i;
      float x = bf2f(m->AT[tau * 72 + lane]) + bf2f(m->Qt[tau * 72 + lane]) * m->nv[lane];
      x = wave_sum(x);
      if (lane == 0) m->den[tau] = fmaxf(fabsf(x), 1.0f);
    }
    __syncthreads();
  }
#pragma unroll
  for (int q = 0; q < 2; ++q) {
    const int tile = w * 2 + q;
    const int I = tile >> 2, vb = tile & 3;
    f32x4 acc = {0.f, 0.f, 0.f, 0.f};
#pragma unroll
    for (int ks = 0; ks < DK / 32; ++ks)
      acc = __builtin_amdgcn_mfma_f32_16x16x32_bf16(lds_frag(m->Qt, I * 16, ks * 32, lane), lds_frag(m->ST, vb * 16, ks * 32, lane), acc, 0, 0, 0);
#pragma unroll
    for (int ks = 0; ks < 2; ++ks)
      acc = __builtin_amdgcn_mfma_f32_16x16x32_bf16(lds_frag(m->AT, I * 16, ks * 32, lane), lds_frag(m->VT, vb * 16, ks * 32, lane), acc, 0, 0, 0);
#pragma unroll
    for (int r = 0; r < 4; ++r) {
      const int tau = I * 16 + (lane >> 4) * 4 + r;
      float o = acc[r];
      if (HASN) o *= frcp(m->den[tau]);
      const int slot = dir ? 63 - tau : tau;
      m->osum[slot * 64 + vb * 16 + (lane & 15)] += o;
    }
  }
  __syncthreads();
}

template <int MIX>
__device__ __forceinline__ void mix_output(PR p, int l, int b, int h, int seg, int j, MixLds* m) {
  constexpr int DK = MixCfg<MIX>::DK;
  constexpr int DPW = DK / 8;
  const int tid = otid();
  const int lane = tid & 63, w = tid >> 6;
  const int nseg = seg ? 128 : 4;
  const int cbase = seg ? 4 : 0;
  const int L = seg ? SEQL : CTXL;
  const int rowbase = seg ? b * SEQL : NLAT + b * CTXL;
  const int cc0 = cbase + j, cc1 = cbase + (nseg - 1 - j);
  const int chain0 = (b * 4 + h) * 2, chain1 = chain0 + 1;
  MixRaw r0, r1;
  mix_fetch<MIX, true>(p, l, b, h, 0, cc0, tid, r0);
  mix_fetch<MIX, true>(p, l, b, h, 1, cc1, tid, r1);
  float sv0[8], sv1[8], gate[8];
  {
    const u16* sb0 = mix_sb(p, MIX) + ((size_t)chain0 * NCH + cc0) * (DK * 64);
    const u16* sb1 = mix_sb(p, MIX) + ((size_t)chain1 * NCH + cc1) * (DK * 64);
#pragma unroll
    for (int i = 0; i < 8; ++i) {
      sv0[i] = (i < DPW) ? bf2f(__builtin_nontemporal_load(sb0 + (w * DPW + i) * 64 + lane)) : 0.f;
      sv1[i] = (i < DPW) ? bf2f(__builtin_nontemporal_load(sb1 + (w * DPW + i) * 64 + lane)) : 0.f;
    }
  }
  const float nv0 = (MIX == 2) ? p.NBML[((size_t)chain0 * NCH + cc0) * 64 + lane] : 0.f;
  const float nv1 = (MIX == 2) ? p.NBML[((size_t)chain1 * NCH + cc1) * 64 + lane] : 0.f;
#pragma unroll
  for (int i = 0; i < 8; ++i) {
    const int t = j * 64 + w + 8 * i;
    const u16* Pr = p.P + (size_t)(rowbase + t) * DIN;
    gate[i] = bf2f(__builtin_nontemporal_load(Pr + ((MIX == 0) ? 1792 : (MIX == 1 ? 2592 : 3632)) + h * 64 + lane));
  }
  __syncthreads();
  for (int idx = tid; idx < 4096; idx += NTH) m->osum[idx] = 0.f;
  mix_output_dir<MIX, 0>(p, l, b, h, tid, r0, sv0, nv0, m);
  mix_output_dir<MIX, 1>(p, l, b, h, tid, r1, sv1, nv1, m);
#pragma unroll
  for (int i = 0; i < 8; ++i) {
    const int tk = w + 8 * i;
    const int t = j * 64 + tk;
    const float o = m->osum[tk * 64 + lane];
    const float ms = wave_sum(o * o) * (1.f / 64.f);
    const float on = o * rsqrtf(ms + EPSV);
    float y;
    int col;
    if (MIX == 0) { y = on * p.hg_norm[l * 256 + h * 64 + lane] * fsilu(gate[i]); col = 256 + h * 64 + lane; }
    else if (MIX == 1) { y = on * p.gla_norm[l * 256 + h * 64 + lane] * fsilu(gate[i]); col = 512 + h * 64 + lane; }
    else { y = fsigmoid(gate[i]) * on * p.ml_norm[l * 256 + h * 64 + lane]; col = 768 + h * 64 + lane; }
    p.YMIX[(size_t)(rowbase + t) * DM + col] = f2bf(y);
  }
}

template <int MIX>
__device__ __forceinline__ void mixA_loop(PR p, int l, MixLds* m) {
  const int NQ = 16 * NCH, G = gridDim.x;
  const int tid = otid();
  int q0 = ((int)blockIdx.x + G - (MIX * 85) % G) % G;
  MixRaw ra, rb;
  MixPar pa, pb;
#define MIXA_FETCH(Q, R) { const int qq_ = min((Q), NQ - 1); const int chain_ = qq_ / NCH, cc_ = qq_ % NCH; \
    mix_fetch<MIX, false>(p, l, chain_ >> 3, (chain_ >> 1) & 3, chain_ & 1, cc_, tid, R); }
#define MIXA_PAR(Q, PP) { const int chain_ = min((Q), NQ - 1) / NCH; mix_params<MIX, false>(p, l, (chain_ >> 1) & 3, chain_ & 1, tid, PP); }
#define MIXA_ITEM(Q, R, PP) { const int chain_ = (Q) / NCH, cc_ = (Q) % NCH; mix_summary<MIX>(p, l, chain_, cc_, R, PP, m); }
  MIXA_FETCH(q0, ra)
  for (; q0 < NQ; q0 += 2 * G) {
    const int q1 = q0 + G, q2 = q0 + 2 * G;
    MIXA_PAR(q0, pa)
    MIXA_FETCH(q1, rb)
    MIXA_ITEM(q0, ra, pa)
    MIXA_PAR(q1, pb)
    MIXA_FETCH(q2, ra)
    if (q1 < NQ) MIXA_ITEM(q1, rb, pb)
  }
#undef MIXA_PAR
#undef MIXA_FETCH
#undef MIXA_ITEM
}
__device__ __forceinline__ void phase_mixA(PR p, int l, unsigned char* smem) {
  MixLds* m = (MixLds*)smem;
  const int n_hy = 256 + (l == 0 ? 256 : 0);
  for (int it = blockIdx.x; it < n_hy; it += gridDim.x) {
    if (it < 256) hyena_latent(p, l, it, smem);
    else hyena_ctx(p, l, it - 256, smem);
  }
  mixA_loop<0>(p, l, m);
  mixA_loop<1>(p, l, m);
  mixA_loop<2>(p, l, m);
}

__device__ __forceinline__ float scan_ld(const u16* q) { return bf2f(__builtin_nontemporal_load(q)); }
__device__ __forceinline__ float scan_ld(const float* q) { return __builtin_nontemporal_load(q); }
__device__ __forceinline__ void scan_st(u16* q, float v) { *q = f2bf(v); }
__device__ __forceinline__ void scan_st(float* q, float v) { *q = v; }
template <class T>
__device__ __forceinline__ void scan_chain(T* ptr, const float* dp, int sz, int dk) {
  float s = 0.f;
  float dv0 = scan_ld(ptr + 0 * (size_t)sz), dv1 = scan_ld(ptr + 1 * (size_t)sz), dv2 = scan_ld(ptr + 2 * (size_t)sz), dv3 = scan_ld(ptr + 3 * (size_t)sz);
  float de0 = dp[0 * dk], de1 = dp[1 * dk], de2 = dp[2 * dk], de3 = dp[3 * dk];
  for (int cc = 0; cc < NCH; cc += 4) {
    float nv0 = 0.f, nv1 = 0.f, nv2 = 0.f, nv3 = 0.f, ne0 = 0.f, ne1 = 0.f, ne2 = 0.f, ne3 = 0.f;
    if (cc + 4 < NCH) {
      nv0 = scan_ld(ptr + (size_t)(cc + 4) * sz); nv1 = scan_ld(ptr + (size_t)(cc + 5) * sz);
      nv2 = scan_ld(ptr + (size_t)(cc + 6) * sz); nv3 = scan_ld(ptr + (size_t)(cc + 7) * sz);
      ne0 = dp[(cc + 4) * dk]; ne1 = dp[(cc + 5) * dk]; ne2 = dp[(cc + 6) * dk]; ne3 = dp[(cc + 7) * dk];
    }
    scan_st(ptr + (size_t)(cc + 0) * sz, s); s = de0 * s + dv0;
    scan_st(ptr + (size_t)(cc + 1) * sz, s); s = de1 * s + dv1;
    scan_st(ptr + (size_t)(cc + 2) * sz, s); s = de2 * s + dv2;
    scan_st(ptr + (size_t)(cc + 3) * sz, s); s = de3 * s + dv3;
    dv0 = nv0; dv1 = nv1; dv2 = nv2; dv3 = nv3; de0 = ne0; de1 = ne1; de2 = ne2; de3 = ne3;
  }
}
__device__ __forceinline__ void scan_chain2(u16* ptr, const float* dp, int sz, int dk) {
  float s0 = 0.f, s1 = 0.f;
#define SC_LD(C) __builtin_nontemporal_load((const uint32_t*)(ptr + (size_t)(C) * sz))
#define SC_ST(C) *(uint32_t*)(ptr + (size_t)(C) * sz) = pk2bf(s0, s1)
#define SC_UP(D, V) s0 = (D) * s0 + bf2f((u16)((V) & 0xFFFF)); s1 = (D) * s1 + bf2f((u16)((V) >> 16))
  uint32_t dv0 = SC_LD(0), dv1 = SC_LD(1), dv2 = SC_LD(2), dv3 = SC_LD(3);
  float de0 = dp[0 * dk], de1 = dp[1 * dk], de2 = dp[2 * dk], de3 = dp[3 * dk];
  for (int cc = 0; cc < NCH; cc += 4) {
    uint32_t nv0 = 0, nv1 = 0, nv2 = 0, nv3 = 0;
    float ne0 = 0.f, ne1 = 0.f, ne2 = 0.f, ne3 = 0.f;
    if (cc + 4 < NCH) {
      nv0 = SC_LD(cc + 4); nv1 = SC_LD(cc + 5); nv2 = SC_LD(cc + 6); nv3 = SC_LD(cc + 7);
      ne0 = dp[(cc + 4) * dk]; ne1 = dp[(cc + 5) * dk]; ne2 = dp[(cc + 6) * dk]; ne3 = dp[(cc + 7) * dk];
    }
    SC_ST(cc + 0); SC_UP(de0, dv0);
    SC_ST(cc + 1); SC_UP(de1, dv1);
    SC_ST(cc + 2); SC_UP(de2, dv2);
    SC_ST(cc + 3); SC_UP(de3, dv3);
    dv0 = nv0; dv1 = nv1; dv2 = nv2; dv3 = nv3; de0 = ne0; de1 = ne1; de2 = ne2; de3 = ne3;
  }
#undef SC_LD
#undef SC_ST
#undef SC_UP
}
__device__ __forceinline__ void phase_scan(PR p, int l) {
  const int gt = blockIdx.x * NTH + otid(), ntot = gridDim.x * NTH;
  const int n0 = 16 * 2048, n1 = 16 * 1024, n2 = 16 * 2048, n3 = 16 * 64;
  for (int e = gt; e < n0 + n1 + n2 + n3; e += ntot) {
    if (e < n0 + n1 + n2) {
      u16* sb; const float* dc; int sz, dk, chain, idx;
      if (e < n0) { sb = p.SBHG; dc = p.DCHG; sz = 4096; dk = 64; chain = e / 2048; idx = (e % 2048) * 2; }
      else if (e < n0 + n1) { const int q = e - n0; sb = p.SBGL; dc = p.DCGL; sz = 2048; dk = 32; chain = q / 1024; idx = (q % 1024) * 2; }
      else { const int q = e - n0 - n1; sb = p.SBML; dc = p.DCML; sz = 4096; dk = 64; chain = q / 2048; idx = (q % 2048) * 2; }
      scan_chain2(sb + ((size_t)chain * NCH) * sz + idx, dc + ((size_t)chain * NCH) * dk + (idx >> 6), sz, dk);
    } else {
      const int q = e - n0 - n1 - n2;
      const int chain = q / 64, d = q % 64;
      scan_chain(p.NBML + ((size_t)chain * NCH) * 64 + d, p.DCML + ((size_t)chain * NCH) * 64 + d, 64, 64);
    }
  }
}

__device__ __forceinline__ void phase_mixC(PR p, int l, unsigned char* smem) {
  MixLds* m = (MixLds*)smem;
  const int nchk = (l == 0) ? 132 : 128;
  const int n_mix = 2 * nchk * 12;
  for (int it = blockIdx.x; it < n_mix; it += gridDim.x) {
    const int rg = it / 12, sub = it % 12;
    const int mix = sub >> 2, h = sub & 3;
    const int b = rg / nchk, c = rg % nchk;
    const int seg = c < 128 ? 1 : 0, j = c < 128 ? c : c - 128;
    if (mix == 0) mix_output<0>(p, l, b, h, seg, j, m);
    else if (mix == 1) mix_output<1>(p, l, b, h, seg, j, m);
    else mix_output<2>(p, l, b, h, seg, j, m);
  }
  {
    float* tl = (float*)smem;
    const int tid = otid();
    const int lane = tid & 63, w = tid >> 6;
    const int nrows = (l == 0) ? NROW : NLAT;
    for (int it = blockIdx.x; it < nrows / 64; it += gridDim.x) {
      const int r0 = it * 64;
      __syncthreads();
      {
        float hv[32];
#pragma unroll
        for (int i = 0; i < 32; ++i) hv[i] = __builtin_nontemporal_load(p.HYRAW + (size_t)((tid >> 6) + 8 * i) * NROW + r0 + (tid & 63));
#pragma unroll
        for (int i = 0; i < 32; ++i) tl[((tid >> 6) + 8 * i) * 65 + (tid & 63)] = hv[i];
      }
      __syncthreads();
      for (int rr = w; rr < 64; rr += 8) {
        float v[4];
        float ss = 0.f;
#pragma unroll
        for (int q = 0; q < 4; ++q) { v[q] = tl[(lane * 4 + q) * 65 + rr]; ss += v[q] * v[q]; }
        const float rs = rsqrtf(wave_sum(ss) * (1.f / 256.f) + EPSV);
        const float4 g = *(const float4*)(p.hy_norm + l * 256 + lane * 4);
        uint2 o;
        o.x = (uint32_t)f2bf(v[0] * rs * g.x) | ((uint32_t)f2bf(v[1] * rs * g.y) << 16);
        o.y = (uint32_t)f2bf(v[2] * rs * g.z) | ((uint32_t)f2bf(v[3] * rs * g.w) << 16);
        *(uint2*)(p.YMIX + (size_t)(r0 + rr) * DM + lane * 4) = o;
      }
    }
  }
}

__device__ __forceinline__ void phase_outproj(PR p, int l, unsigned char* smem) {
  const int nM = ((l == 0) ? NROW : NLAT) / 256;
  u16* YO_ = p.YOB;
  TileIter ti;
  for (int it = ti.next(nM * 4); it >= 0; it = ti.next(nM * 4)) {
    int pm, pn;
    g8_tile(it, nM, 4, pm, pn);
    gemm256<false, false, 1>(p.YMIX, p.YMIX, 1 << 30, DM, p.WoutT + (size_t)l * 1024 * 1024, DM, pm * 256, pn * 256, smem,
                   [&](int row, int col, const float4& v, const float4&) {
                     *(uint2*)(YO_ + (size_t)row * DM + col) = make_uint2(pk2bf(v.x, v.y), pk2bf(v.z, v.w));
                   });
  }
}

__device__ __forceinline__ void phase_post1(PR p, int l) {
  const int tid_ = otid();
  const int lane = tid_ & 63;
  const int gw = blockIdx.x * 8 + (tid_ >> 6), nw = gridDim.x * 8;
  const float* ng1 = p.norm_g + (l * 4 + 1) * DM;
  const float* ng2 = p.norm_g + (l * 4 + 2) * DM;
  const int nrows = (l == 0) ? NROW : NLAT;
  for (int r = gw; r < nrows; r += nw) {
    const float* mod = p.MOD + (l * 3 + mod_index(r)) * 6144;
    float4 yv[4], xv[4];
    float ss = 0.f;
#pragma unroll
    for (int q = 0; q < 4; ++q) {
      const u32x2v yb = __builtin_nontemporal_load((const u32x2v*)(p.YOB + (size_t)r * DM + q * 256 + lane * 4));
      yv[q] = make_float4(bf2f((u16)(yb.x & 0xFFFF)), bf2f((u16)(yb.x >> 16)), bf2f((u16)(yb.y & 0xFFFF)), bf2f((u16)(yb.y >> 16)));
      ss += yv[q].x * yv[q].x + yv[q].y * yv[q].y + yv[q].z * yv[q].z + yv[q].w * yv[q].w;
    }
    ss = wave_sum(ss);
    const float rs = rsqrtf(ss * (1.f / DM) + EPSV);
    float s2 = 0.f;
#pragma unroll
    for (int q = 0; q < 4; ++q) {
      const int e = q * 256 + lane * 4;
      const float4 gv = *(const float4*)(ng1 + e);
      const float4 g1 = *(const float4*)(mod + 2048 + e);
      float4 xx = ldx4(p.X + (size_t)r * DM + e);
      xx.x += g1.x * (yv[q].x * rs * gv.x); xx.y += g1.y * (yv[q].y * rs * gv.y);
      xx.z += g1.z * (yv[q].z * rs * gv.z); xx.w += g1.w * (yv[q].w * rs * gv.w);
      xv[q] = xx;
      stx4(p.X + (size_t)r * DM + e, xx);
      s2 += xx.x * xx.x + xx.y * xx.y + xx.z * xx.z + xx.w * xx.w;
    }
    s2 = wave_sum(s2);
    const float rs2 = rsqrtf(s2 * (1.f / DM) + EPSV);
#pragma unroll
    for (int q = 0; q < 4; ++q) {
      const int e = q * 256 + lane * 4;
      const float4 gv = *(const float4*)(ng2 + e);
      const float4 sh = *(const float4*)(mod + 3072 + e);
      const float4 sc = *(const float4*)(mod + 4096 + e);
      float4 hv;
      hv.x = xv[q].x * rs2 * gv.x * (1.f + sc.x) + sh.x; hv.y = xv[q].y * rs2 * gv.y * (1.f + sc.y) + sh.y;
      hv.z = xv[q].z * rs2 * gv.z * (1.f + sc.z) + sh.z; hv.w = xv[q].w * rs2 * gv.w * (1.f + sc.w) + sh.w;
      uint2 o;
      o.x = pk2bf(hv.x, hv.y);
      o.y = pk2bf(hv.z, hv.w);
      *(uint2*)(p.HN + (size_t)r * DM + e) = o;
      uint2 o2;
      o2.x = pk2bf(hv.x - bf2f((u16)(o.x & 0xFFFF)), hv.y - bf2f((u16)(o.x >> 16)));
      o2.y = pk2bf(hv.z - bf2f((u16)(o.y & 0xFFFF)), hv.w - bf2f((u16)(o.y >> 16)));
      *(uint2*)(p.HLO + (size_t)r * DM + e) = o2;
    }
  }
}

__device__ __forceinline__ void convert_experts(PR p, int l, unsigned char* smem) {
  float* T = (float*)smem;
  int* sidx = (int*)(smem + 70000);
  const int tid = otid();
  int nextt = (tid == 0) ? atomicAdd(&p.WQ[l], 4) : 0;
  for (;;) {
    __syncthreads();
    if (tid == 0) *sidx = nextt;
    __syncthreads();
    const int base = __builtin_amdgcn_readfirstlane(*sidx);
    if (base >= 256 * 48) break;
    if (tid == 0) nextt = atomicAdd(&p.WQ[l], 4);
  for (int it = base; it < base + 4; ++it) {
    const int e = it / 48, q = it % 48;
    const float* src; u16* dst; int ldn, K, k0, n0; bool gu;
    if (q < 32) { gu = true; k0 = (q >> 1) * 64; n0 = (q & 1) * 256; ldn = 512; K = 1024;
      src = p.exp_w_gu + ((size_t)l * 256 + e) * DM * 512; dst = p.EGU + (size_t)e * 512 * 1024; }
    else { const int q2 = q - 32; gu = false; k0 = (q2 >> 2) * 64; n0 = (q2 & 3) * 256; ldn = 1024; K = 256;
      src = p.exp_w_down + ((size_t)l * 256 + e) * 256 * DM; dst = p.EDN + (size_t)e * 1024 * 256; }
    const float* sp0 = src + (size_t)(k0 + (tid >> 6)) * ldn + n0 + (tid & 63) * 4;
#define NTL(P_) __builtin_nontemporal_load((const f32x4*)(P_))
    const f32x4 v0 = NTL(sp0), v1 = NTL(sp0 + (size_t)8 * ldn), v2 = NTL(sp0 + (size_t)16 * ldn), v3 = NTL(sp0 + (size_t)24 * ldn),
                v4 = NTL(sp0 + (size_t)32 * ldn), v5 = NTL(sp0 + (size_t)40 * ldn), v6 = NTL(sp0 + (size_t)48 * ldn), v7 = NTL(sp0 + (size_t)56 * ldn);
#undef NTL
    __syncthreads();
    float* tq = T + (tid >> 6) * 260 + (tid & 63) * 4;
    *(f32x4*)(tq) = v0; *(f32x4*)(tq + 8 * 260) = v1; *(f32x4*)(tq + 16 * 260) = v2; *(f32x4*)(tq + 24 * 260) = v3;
    *(f32x4*)(tq + 32 * 260) = v4; *(f32x4*)(tq + 40 * 260) = v5; *(f32x4*)(tq + 48 * 260) = v6; *(f32x4*)(tq + 56 * 260) = v7;
    __syncthreads();
#pragma unroll
    for (int i = 0; i < 4; ++i) {
      const int c = tid + 512 * i;
      const int n = c & 255, kc = c >> 8;
      const float* tp = T + (kc * 8) * 260 + n;
      uint4 o;
      o.x = pk2bf(tp[0], tp[260]); o.y = pk2bf(tp[2 * 260], tp[3 * 260]);
      o.z = pk2bf(tp[4 * 260], tp[5 * 260]); o.w = pk2bf(tp[6 * 260], tp[7 * 260]);
      const int col = n0 + n;
      int orow;
      if (gu) orow = (col < 256) ? ((col >> 4) * 32 + (col & 15)) : (((col - 256) >> 4) * 32 + 16 + (col & 15));
      else orow = col;
      *(uint4*)(dst + (size_t)orow * K + k0 + kc * 8) = o;
    }
  }
  }
}

__device__ __forceinline__ void phase_router(PR p, int l, unsigned char* smem) {
  const int tid = otid();
  const int nrows = (l == 0) ? NROW : NLAT;
  int* cnt = p.CNT + l * 256;
  float* LG = p.YO;
  for (int pm = blockIdx.x; pm < nrows / 256; pm += gridDim.x) {
    gemm256<false, false, 1>(p.HN, p.HLO, 32, DM, p.RWT + (size_t)l * 256 * 3072, 3072, pm * 256, 0, smem,
                   [&](int row, int col, const float4& v, const float4&) { *(float4*)(LG + (size_t)row * 256 + col) = v; });
    __syncthreads();
    {
      const int t2 = otid();
      const int lane = t2 & 63, w = t2 >> 6;
      const float4 rb = *(const float4*)(p.router_b + l * 256 + lane * 4);
      f32x4 lgn = __builtin_nontemporal_load((const f32x4*)(LG + (size_t)(pm * 256 + w) * 256 + lane * 4));
      int prow = 0, pmye = 0, ppos = 0;
      float pwv = 0.f;
      for (int rr = w; rr < 256; rr += 8) {
        const int row = pm * 256 + rr;
        const f32x4 lg_ = lgn;
        lgn = __builtin_nontemporal_load((const f32x4*)(LG + (size_t)(pm * 256 + min(rr + 8, 255)) * 256 + lane * 4));
        const float4 lg = make_float4(lg_[0], lg_[1], lg_[2], lg_[3]);
        const float s0 = sigmoidf_(lg.x), s1 = sigmoidf_(lg.y), s2 = sigmoidf_(lg.z), s3 = sigmoidf_(lg.w);
        float v0 = s0 + rb.x, v1 = s1 + rb.y, v2 = s2 + rb.z, v3 = s3 + rb.w;
        float m1 = fmaxf(fmaxf(v0, v1), fmaxf(v2, v3));
        float m2 = fmaxf(fmaxf(fminf(v0, v1), fminf(v2, v3)), fminf(fmaxf(v0, v1), fmaxf(v2, v3)));
#define RT_MERGE2(CTRL) { const float o1 = dppf<CTRL>(m1), o2 = dppf<CTRL>(m2); \
          const float n1 = fmaxf(m1, o1), n2 = fmaxf(fminf(m1, o1), fmaxf(m2, o2)); m1 = n1; m2 = n2; }
        RT_MERGE2(0xB1) RT_MERGE2(0x4E) RT_MERGE2(0x141)
#undef RT_MERGE2
        const float gsc = m1 + m2;
        const int g = lane >> 3;
        int rank = 0;
#pragma unroll
        for (int gp = 0; gp < 8; ++gp) {
          const float og = shu(gsc, gp * 8);
          rank += (og > gsc || (og == gsc && gp < g)) ? 1 : 0;
        }
        if (rank >= 4) { v0 = -INFINITY; v1 = -INFINITY; v2 = -INFINITY; v3 = -INFINITY; }
        int mye = 0;
        float wsel = 0.f;
#pragma unroll
        for (int k = 0; k < 8; ++k) {
          float bv = v0; int bi = lane * 4;
          if (v1 > bv) { bv = v1; bi = lane * 4 + 1; }
          if (v2 > bv) { bv = v2; bi = lane * 4 + 2; }
          if (v3 > bv) { bv = v3; bi = lane * 4 + 3; }
#define RT_AMX(CTRL) { const float ov = dppf<CTRL>(bv); const int oi = dppi<CTRL>(bi); \
            if (ov > bv || (ov == bv && oi < bi)) { bv = ov; bi = oi; } }
          RT_AMX(0xB1) RT_AMX(0x4E) RT_AMX(0x141) RT_AMX(0x140)
#undef RT_AMX
          {
            float fb = shu(bv, 0); int fi = __builtin_amdgcn_readlane(bi, 0);
#pragma unroll
            for (int k2 = 1; k2 < 4; ++k2) {
              const float ov = shu(bv, 16 * k2); const int oi = __builtin_amdgcn_readlane(bi, 16 * k2);
              if (ov > fb || (ov == fb && oi < fi)) { fb = ov; fi = oi; }
            }
            bv = fb; bi = fi;
          }
          if (bi == lane * 4 + 0) v0 = -INFINITY;
          if (bi == lane * 4 + 1) v1 = -INFINITY;
          if (bi == lane * 4 + 2) v2 = -INFINITY;
          if (bi == lane * 4 + 3) v3 = -INFINITY;
          if (lane == k) mye = bi;
          {
            const int sub_ = bi & 3;
            const float ssel = (sub_ == 0) ? s0 : (sub_ == 1 ? s1 : (sub_ == 2 ? s2 : s3));
            const float wk = shu(ssel, bi >> 2);
            if (lane == k) wsel = wk;
          }
        }
        const float wv = (lane < 8) ? wsel : 0.f;
        const float wsum = wave_sum(wv);
        if (rr != w && lane < 8) {
          p.LTOK[(size_t)pmye * CAP + ppos] = prow;
          p.LW[(size_t)pmye * CAP + ppos] = pwv;
          p.TOKSLOT[(size_t)prow * 8 + lane] = pmye * CAP + ppos;
        }
        if (lane < 8) ppos = atomicAdd(&cnt[mye], 1);
        prow = row; pmye = mye; pwv = wv * (2.5f / wsum);
      }
      if (lane < 8) {
        p.LTOK[(size_t)pmye * CAP + ppos] = prow;
        p.LW[(size_t)pmye * CAP + ppos] = pwv;
        p.TOKSLOT[(size_t)prow * 8 + lane] = pmye * CAP + ppos;
      }
    }
  }
  {
    const int nM = nrows / 256;
    int* sidx = (int*)(smem + 131072 + 2056);
    int nextt = (otid() == 0) ? atomicAdd(&p.WQ[4 + l], 1) : 0;
    for (;;) {
      __syncthreads();
      if (otid() == 0) *sidx = nextt;
      __syncthreads();
      const int it = __builtin_amdgcn_readfirstlane(*sidx);
      if (it >= nM * 2) break;
      if (otid() == 0) nextt = atomicAdd(&p.WQ[4 + l], 1);
      int pm, pn;
      g8_tile(it, nM, 2, pm, pn);
      u16* AS_ = p.ACTSH;
      gemm256<true, false, 1>(p.HN, p.HN, 1 << 30, DM, p.ShGuT + (size_t)l * 512 * 1024, DM, pm * 256, pn * 256, smem,
                    [&](int row, int ac, const float4& g, const float4& u) {
                      *(uint2*)(AS_ + (size_t)row * 256 + ac) = make_uint2(pk2bf(siluf_(g.x) * u.x, siluf_(g.y) * u.y), pk2bf(siluf_(g.z) * u.z, siluf_(g.w) * u.w));
                    });
    }
  }
  convert_experts(p, l, smem);
}

__device__ __forceinline__ int expert_offsets(const int* cnt, int* offs, int* tl) {
  __syncthreads();
  if (threadIdx.x < 256) tl[threadIdx.x] = cnt[threadIdx.x];
  __syncthreads();
  if (threadIdx.x == 0) {
    int o = 0, t = 0;
#pragma unroll 8
    for (int e = 0; e < 256; ++e) { const int c = tl[e]; offs[e] = o; tl[e] = t; o += c; t += (c + 255) >> 8; }
    offs[256] = o; tl[256] = t;
  }
  __syncthreads();
  return tl[256];
}
__device__ __forceinline__ int find_expert(const int* tl, int tile) {
  int lo = 0, hi = 255;
  while (lo < hi) { const int mid = (lo + hi + 1) >> 1; if (tl[mid] <= tile) lo = mid; else hi = mid - 1; }
  return lo;
}

__device__ __forceinline__ void phase_gu(PR p, int l, unsigned char* smem) {
  int* offs = (int*)(smem + 131072);
  int* tl = offs + 257;
  const int* cnt = p.CNT + l * 256;
  const int ntile = expert_offsets(cnt, offs, tl);
  {
    TileIter ti;
    for (int it = ti.next(ntile * 2); it >= 0; it = ti.next(ntile * 2)) {
      const int tile = it >> 1, nt = it & 1;
      const int e = __builtin_amdgcn_readfirstlane(find_expert(tl, tile));
      const int mt = tile - __builtin_amdgcn_readfirstlane(tl[e]);
      const int ce = __builtin_amdgcn_readfirstlane(cnt[e]);
      const int nvalid = min(256, ce - mt * 256);
      const int obase = __builtin_amdgcn_readfirstlane(offs[e]) + mt * 256;
      u16* ACT_ = p.ACT;
      const float* LW_ = p.LW + (size_t)e * CAP + mt * 256;
      gemm256<true, true, 1>(p.HN, p.HN, 1 << 30, DM, p.EGU + (size_t)e * 512 * 1024, DM, 0, nt * 256, smem,
                          [&](int row, int ac, const float4& g, const float4& u) {
                            if (row < nvalid) {
                              const float w_ = LW_[row];
                              *(uint2*)(ACT_ + (size_t)(obase + row) * 256 + ac) =
                                  make_uint2(pk2bf(siluf_(g.x) * u.x * w_, siluf_(g.y) * u.y * w_), pk2bf(siluf_(g.z) * u.z * w_, siluf_(g.w) * u.w * w_));
                            }
                          },
                          p.LTOK + (size_t)e * CAP + mt * 256, nvalid);
    }
  }
  {
    const int nM = ((l == 0) ? NROW : NLAT) / 256;
    int* sidx = (int*)(smem + 131072 + 2056);
    int nextt = (otid() == 0) ? atomicAdd(&p.WQ[2 + l], 1) : 0;
    for (;;) {
      __syncthreads();
      if (otid() == 0) *sidx = nextt;
      __syncthreads();
      const int it = __builtin_amdgcn_readfirstlane(*sidx);
      if (it >= nM * 4) break;
      if (otid() == 0) nextt = atomicAdd(&p.WQ[2 + l], 1);
      int pm, pn;
      g8_tile(it, nM, 4, pm, pn);
      u16* F_ = p.FSH;
      gemm256<false, false, 1>(p.ACTSH, p.ACTSH, 1 << 30, 256, p.ShDnT + (size_t)l * 1024 * 256, 256, pm * 256, pn * 256, smem,
                     [&](int row, int col, const float4& v, const float4&) {
                       *(uint2*)(F_ + (size_t)row * DM + col) = make_uint2(pk2bf(v.x, v.y), pk2bf(v.z, v.w));
                     });
    }
  }
}

__device__ __forceinline__ void phase_down(PR p, int l, unsigned char* smem) {
  int* offs = (int*)(smem + 131072);
  int* tl = offs + 257;
  const int* cnt = p.CNT + l * 256;
  const int ntile = expert_offsets(cnt, offs, tl);
  TileIter ti;
  for (int it = ti.next(ntile * 4); it >= 0; it = ti.next(ntile * 4)) {
    const int tile = it >> 2, nt = it & 3;
    const int e = __builtin_amdgcn_readfirstlane(find_expert(tl, tile));
    const int mt = tile - __builtin_amdgcn_readfirstlane(tl[e]);
    const int ce = __builtin_amdgcn_readfirstlane(cnt[e]);
    const int nvalid = min(256, ce - mt * 256);
    const int obase = __builtin_amdgcn_readfirstlane(offs[e]) + mt * 256;
    u16* YR_ = p.YR;
    gemm256<false, false, 1>(p.ACT, p.ACT, 1 << 30, 256, p.EDN + (size_t)e * 1024 * 256, 256, obase, nt * 256, smem,
                          [&](int row, int col, const float4& v, const float4&) {
                            if (row - obase < nvalid) *(uint2*)(YR_ + (size_t)row * DM + col) = make_uint2(pk2bf(v.x, v.y), pk2bf(v.z, v.w));
                          },
                          nullptr, nvalid);
  }
}

__device__ __forceinline__ void phase_post2(PR p, int l, unsigned char* smem) {
  int* offs = (int*)smem;
  int* tl = offs + 257;
  expert_offsets(p.CNT + l * 256, offs, tl);
  const int tid_ = otid();
  const int lane = tid_ & 63;
  const int gw = blockIdx.x * 8 + (tid_ >> 6), nw = gridDim.x * 8;
  const float* ng3 = p.norm_g + (l * 4 + 3) * DM;
  const int nrows = (l == 0) ? NROW : NLAT;
  int slot_next = (gw < nrows && lane < 8) ? p.TOKSLOT[(size_t)gw * 8 + lane] : 0;
  for (int r = gw; r < nrows; r += nw) {
    const float* mod = p.MOD + (l * 3 + mod_index(r)) * 6144;
    const int slotv = slot_next;
    if (r + nw < nrows && lane < 8) slot_next = p.TOKSLOT[(size_t)(r + nw) * 8 + lane];
    uint2 fb[4], yb[8][4];
#pragma unroll
    for (int q = 0; q < 4; ++q) { const u32x2v t_ = __builtin_nontemporal_load((const u32x2v*)(p.FSH + (size_t)r * DM + q * 256 + lane * 4)); fb[q] = make_uint2(t_.x, t_.y); }
#pragma unroll
    for (int k = 0; k < 8; ++k) {
      const int v = __builtin_amdgcn_readlane(slotv, k);
      const int e = v / CAP, pos = v - e * CAP;
      const u16* yr = p.YR + (size_t)(offs[e] + pos) * DM;
#pragma unroll
      for (int q = 0; q < 4; ++q) { const u32x2v t_ = __builtin_nontemporal_load((const u32x2v*)(yr + q * 256 + lane * 4)); yb[k][q] = make_uint2(t_.x, t_.y); }
    }
    float4 fv[4];
#pragma unroll
    for (int q = 0; q < 4; ++q) {
      fv[q] = make_float4(bf2f((u16)(fb[q].x & 0xFFFF)), bf2f((u16)(fb[q].x >> 16)), bf2f((u16)(fb[q].y & 0xFFFF)), bf2f((u16)(fb[q].y >> 16)));
#pragma unroll
      for (int k = 0; k < 8; ++k) {
        fv[q].x += bf2f((u16)(yb[k][q].x & 0xFFFF)); fv[q].y += bf2f((u16)(yb[k][q].x >> 16));
        fv[q].z += bf2f((u16)(yb[k][q].y & 0xFFFF)); fv[q].w += bf2f((u16)(yb[k][q].y >> 16));
      }
    }
    float ss = 0.f;
#pragma unroll
    for (int q = 0; q < 4; ++q) ss += fv[q].x * fv[q].x + fv[q].y * fv[q].y + fv[q].z * fv[q].z + fv[q].w * fv[q].w;
    ss = wave_sum(ss);
    const float rs = rsqrtf(ss * (1.f / DM) + EPSV);
    float s2 = 0.f;
#pragma unroll
    for (int q = 0; q < 4; ++q) {
      const int e = q * 256 + lane * 4;
      const float4 gv = *(const float4*)(ng3 + e);
      const float4 g2 = *(const float4*)(mod + 5120 + e);
      float4 xx = ldx4(p.X + (size_t)r * DM + e);
      xx.x += g2.x * (fv[q].x * rs * gv.x); xx.y += g2.y * (fv[q].y * rs * gv.y);
      xx.z += g2.z * (fv[q].z * rs * gv.z); xx.w += g2.w * (fv[q].w * rs * gv.w);
      if (l == 1) *(float4*)(p.out + (size_t)r * DM + e) = xx;
      else stx4(p.X + (size_t)r * DM + e, xx);
      fv[q] = xx;
      s2 += xx.x * xx.x + xx.y * xx.y + xx.z * xx.z + xx.w * xx.w;
    }
    if (l == 0) {
      s2 = wave_sum(s2);
      const float rs2 = rsqrtf(s2 * (1.f / DM) + EPSV);
      const float* gn = p.norm_g + (1 * 4 + 0) * DM;
      const float* mod1 = p.MOD + (1 * 3 + mod_index(r)) * 6144;
#pragma unroll
      for (int q = 0; q < 4; ++q) {
        const int e = q * 256 + lane * 4;
        const float4 gv = *(const float4*)(gn + e);
        const float4 sh = *(const float4*)(mod1 + e);
        const float4 sc = *(const float4*)(mod1 + 1024 + e);
        uint2 o;
        o.x = pk2bf(fv[q].x * rs2 * gv.x * (1.f + sc.x) + sh.x, fv[q].y * rs2 * gv.y * (1.f + sc.y) + sh.y);
        o.y = pk2bf(fv[q].z * rs2 * gv.z * (1.f + sc.z) + sh.z, fv[q].w * rs2 * gv.w * (1.f + sc.w) + sh.w);
        *(uint2*)(p.HN + (size_t)r * DM + e) = o;
      }
    }
  }
}

#define SMEM_BYTES (16384 * 8 + 256 * 8 + 64)

__device__ __forceinline__ void grid_barrier(PR p, unsigned char* smem) {
  XcdBarrier b;
  b.bar = p.bar; b.x = xb_xcc_id(); b.st = (volatile LAS unsigned*)(smem + SMEM_BYTES);
  xcd_barrier(b);
}

__global__ void __launch_bounds__(NTH, 2) k_fused(Params p_unused) {
  extern __shared__ __align__(16) unsigned char smem[];
  PR p = *(const __attribute__((address_space(4))) Params*)__builtin_amdgcn_kernarg_segment_ptr();
  uint4* xbw = (uint4*)(smem + SMEM_BYTES);
  if (threadIdx.x == 0) *xbw = make_uint4(0u, 0u, 0u, 0u);
  __syncthreads();
  (void)xcd_barrier_post(p.bar, (volatile LAS unsigned*)xbw);
  int* xinfo = (int*)(smem + XINFO_OFF);
  if (threadIdx.x == 0) xinfo[1] = (int)atomicAdd(p.bar + XCEN_WORD + xb_xcc_id(), 1u);
  phase_prologue(p, smem);
  grid_barrier(p, smem);
  if (threadIdx.x == 0) {
    const unsigned me = xb_xcc_id();
    unsigned nxp = 0, ord = 0, mine = 0, tot = 0; bool even = true;
    for (unsigned j = 0; j < 16; ++j) {
      const unsigned c = __hip_atomic_load(p.bar + XCEN_WORD + j, __ATOMIC_RELAXED, __HIP_MEMORY_SCOPE_AGENT);
      if (c) { ++nxp; if (j < me) ++ord; }
      if (j == me) mine = c;
      tot += c;
    }
    for (unsigned j = 0; j < 16; ++j) {
      const unsigned c = __hip_atomic_load(p.bar + XCEN_WORD + j, __ATOMIC_RELAXED, __HIP_MEMORY_SCOPE_AGENT);
      if (c && c != mine) even = false;
    }
    even = even && (tot == gridDim.x) && (mine > 0);
    xinfo[0] = (int)ord; xinfo[2] = even ? (int)mine : 0; xinfo[3] = (int)nxp;
  }
  __syncthreads();
#define LAYER_BODY(l) \
    if (l == 0) { phase_norm1(p, l); grid_barrier(p, smem); } \
    phase_inproj(p, l, smem); \
    grid_barrier(p, smem); \
    phase_mixA(p, l, smem); \
    grid_barrier(p, smem); \
    phase_scan(p, l); \
    grid_barrier(p, smem); \
    phase_mixC(p, l, smem); \
    grid_barrier(p, smem); \
    phase_outproj(p, l, smem); \
    grid_barrier(p, smem); \
    phase_post1(p, l); \
    grid_barrier(p, smem); \
    phase_router(p, l, smem); \
    grid_barrier(p, smem); \
    phase_gu(p, l, smem); \
    grid_barrier(p, smem); \
    phase_down(p, l, smem); \
    grid_barrier(p, smem); \
    phase_post2(p, l, smem); \
    grid_barrier(p, smem);
  LAYER_BODY(0)
  LAYER_BODY(1)
#undef LAYER_BODY
}

extern "C" void kernel_launch(void* const* d_in, const int* in_sizes, int n_in, void* d_out, int out_size, void* d_ws,
                              size_t ws_size, hipStream_t stream) {
  Params p{};
  const float* const* in = (const float* const*)d_in;
  p.x = in[0]; p.c = in[1]; p.ctx = in[2]; p.c_ctx = in[3]; p.ada_w = in[4]; p.ada_b = in[5]; p.norm_g = in[6];
  p.w_in = in[7]; p.w_out = in[8]; p.hy_conv_w = in[9]; p.hy_conv_b = in[10]; p.hy_w1 = in[11]; p.hy_b1 = in[12];
  p.hy_w2 = in[13]; p.hy_b2 = in[14]; p.hy_w3 = in[15]; p.hy_freq = in[16]; p.hy_bias = in[17]; p.hy_norm = in[18];
  p.hg_lb_logits = in[19]; p.hg_norm = in[20]; p.gla_a_up = in[21]; p.gla_a_b = in[22]; p.gla_norm = in[23];
  p.ml_conv_w = in[24]; p.ml_conv_b = in[25]; p.ml_gate_b = in[26]; p.ml_norm = in[27];
  p.router_w = in[28]; p.router_b = in[29]; p.exp_w_gu = in[30]; p.exp_w_down = in[31]; p.sh_w_gu = in[32]; p.sh_w_down = in[33];
  p.out = (float*)d_out;
  size_t off = 0;
  auto alloc = [&](size_t bytes) { void* r = (char*)d_ws + off; off += (bytes + 255) & ~(size_t)255; return r; };
  p.bar = (unsigned*)alloc(16384);
  p.X = (u16*)alloc((size_t)NROW * DM * 4);
  p.MOD = (float*)alloc(2 * 3 * 6144 * 4);
  p.LBv = (float*)alloc(2 * 256 * 4);
  p.HFT = (float*)alloc((size_t)2 * 1024 * 8192 * 4);
  p.HFTC = (float*)alloc((size_t)1024 * 256 * 4);
  p.PT = (u16*)alloc((size_t)768 * NROW * 4);
  p.HS = (uint32_t*)alloc((size_t)256 * 2 * 16384 * 8);
  p.ZS = (float2*)alloc((size_t)256 * 8192 * 8);
  p.HN = (u16*)alloc((size_t)NROW * DM * 2);
  p.P = (u16*)alloc((size_t)NROW * DIN * 4);
  p.YMIX = (u16*)alloc((size_t)NROW * DM * 2);
  p.YO = (float*)alloc((size_t)NROW * DM * 4);
  p.HYRAW = (float*)alloc((size_t)NROW * 256 * 4);
  p.SBHG = (u16*)alloc((size_t)16 * NCH * 4096 * 2);
  p.SBGL = (u16*)alloc((size_t)16 * NCH * 2048 * 2);
  p.SBML = (u16*)alloc((size_t)16 * NCH * 4096 * 2);
  p.NBML = (float*)alloc((size_t)16 * NCH * 64 * 4);
  p.DCHG = (float*)alloc((size_t)16 * NCH * 64 * 4);
  p.DCGL = (float*)alloc((size_t)16 * NCH * 32 * 4);
  p.DCML = (float*)alloc((size_t)16 * NCH * 64 * 4);
  p.CNT = (int*)alloc(2 * 256 * 4);
  p.WQ = (int*)alloc(256);
  p.LTOK = (int*)alloc((size_t)256 * CAP * 4);
  p.LW = (float*)alloc((size_t)256 * CAP * 4);
  p.TOKSLOT = (int*)alloc((size_t)NROW * 8 * 4);
  p.ACT = (u16*)alloc((size_t)(NSLOT + 512) * 256 * 2);
  p.ACTSH = (u16*)alloc((size_t)NROW * 256 * 2);
  p.FSH = (u16*)alloc((size_t)NROW * DM * 2);
  p.YOB = (u16*)alloc((size_t)NROW * DM * 2);
  p.YR = (u16*)alloc((size_t)(NSLOT + 512) * DM * 2);
  p.WinT = (u16*)alloc((size_t)2 * 4096 * 1024 * 2);
  p.WoutT = (u16*)alloc((size_t)2 * 1024 * 1024 * 2);
  p.ShGuT = (u16*)alloc((size_t)2 * 512 * 1024 * 2);
  p.ShDnT = (u16*)alloc((size_t)2 * 1024 * 256 * 2);
  p.RWT = (u16*)alloc((size_t)2 * 256 * 3072 * 2);
  p.HLO = (u16*)alloc((size_t)NROW * DM * 2);
  p.EGU = (u16*)alloc((size_t)256 * 512 * 1024 * 2);
  p.EDN = (u16*)alloc((size_t)256 * 1024 * 256 * 2);
  if (off > ws_size) { fprintf(stderr, "workspace too small: need %zu have %zu\n", off, ws_size); return; }
  static int grid = 0;
  const size_t dyn = SMEM_BYTES + 16 + 64;
  if (!grid) {
    int dev = 0, cus = 0, per_cu = 0;
    hipGetDevice(&dev);
    hipDeviceGetAttribute(&cus, hipDeviceAttributeMultiprocessorCount, dev);
    (void)hipFuncSetAttribute((const void*)k_fused, hipFuncAttributeMaxDynamicSharedMemorySize, (int)dyn);
    (void)hipOccupancyMaxActiveBlocksPerMultiprocessor(&per_cu, k_fused, NTH, dyn);
    if (per_cu < 1) { fprintf(stderr, "occupancy query says 0 blocks per CU\n"); per_cu = 1; }
    grid = cus;
  }
  (void)hipMemsetAsync(p.bar, 0, 4096 * sizeof(unsigned), stream);
  hipLaunchKernelGGL(k_fused, dim3(grid), dim3(NTH), dyn, stream, p);
}
```
